# Optimizing an MI355X kernel written in HIP

```python
import math
import jax, jax.numpy as jnp
from jax import lax
import numpy as np

D_MODEL = 2048
BATCH = 4
SEQ = 2048
DEPTH = 1
DEC_BATCH = 128
DEC_SEQ = 4
PAST_LEN = 16384
PAGE_SIZE = 128

PLE_DIM = 256
HG_HEADS = 8
HG_K = 128
HG_V = 128
HG_WIDTH = HG_HEADS * HG_V
GLA_HEADS = 4
GLA_K = 128
GLA_V = 256
GLA_KW = GLA_HEADS * GLA_K
GLA_VW = GLA_HEADS * GLA_V
GLA_GATE_RANK = 16
GLA_GATE_NORM = 16.0
BRANCH_W = 1024
N_BRANCH = 2
D_FF = -(-8 * D_MODEL // (3 * 256)) * 256
CHUNK = 32
EPS = 1e-6
IN_SIZES = (HG_HEADS * HG_K, HG_HEADS * HG_K, HG_WIDTH, HG_WIDTH,
            GLA_KW, GLA_KW, GLA_VW, GLA_VW, GLA_GATE_RANK,
            N_BRANCH * D_MODEL)
IN_COLS = sum(IN_SIZES)

kernel_name = "hgrn2_gla_parallel_decoder_step"


def rmsnorm(x, g):
    xf = x.astype(jnp.float32)
    y = xf * lax.rsqrt(jnp.mean(xf * xf, axis=-1, keepdims=True) + EPS)
    return (y * g.astype(jnp.float32)).astype(x.dtype)


def rms_head(o, g):
    return o * lax.rsqrt(jnp.mean(o * o, axis=-1, keepdims=True) + EPS) * g.astype(jnp.float32)


def gated_linear_scan(q, k, v, logf, s0):
    b_, t_, h_, _ = q.shape
    dv = v.shape[-1]
    c = math.gcd(t_, CHUNK)
    n = t_ // c
    rs = lambda a: a.reshape(b_, n, c, h_, a.shape[-1])
    q, k, v, logf = rs(q), rs(k), rs(v), rs(logf)
    cum = jnp.cumsum(logf, axis=2)
    last = cum[:, :, -1:]
    ref = cum[:, :, c // 2:c // 2 + 1]
    qe = q * jnp.exp(cum - ref)
    ke = k * jnp.exp(ref - cum)
    att = jnp.einsum('bnthk,bnshk->bnhts', qe, ke)
    mask = jnp.tril(jnp.ones((c, c), dtype=bool))
    att = jnp.where(mask, att, 0.0)
    o_intra = jnp.einsum('bnhts,bnshv->bnthv', att, v)
    q_in = q * jnp.exp(cum)
    k_out = k * jnp.exp(last - cum)
    decay = jnp.exp(last[:, :, 0])

    def step(s, inp):
        qi, ki, vi, di = inp
        o = jnp.einsum('bthk,bhkv->bthv', qi, s)
        s = s * di[..., None] + jnp.einsum('bthk,bthv->bhkv', ki, vi)
        return s, o

    xs = (jnp.moveaxis(q_in, 1, 0), jnp.moveaxis(k_out, 1, 0),
          jnp.moveaxis(v, 1, 0), jnp.moveaxis(decay, 1, 0))
    s_fin, o_inter = lax.scan(step, s0, xs)
    o = o_intra + jnp.moveaxis(o_inter, 0, 1)
    return o.reshape(b_, t_, h_, dv), s_fin


def hgrn2_branch(q_raw, f_raw, i_raw, g_raw, lb, gain, s0):
    bsz, t_, _ = q_raw.shape
    f32 = jnp.float32
    q = jax.nn.silu(q_raw.astype(f32).reshape(bsz, t_, HG_HEADS, HG_K)) * (HG_K ** -0.5)
    fr = f_raw.astype(f32).reshape(bsz, t_, HG_HEADS, HG_K)
    lbh = lb.reshape(HG_HEADS, HG_K)
    logf = jnp.log(lbh + (1.0 - lbh) * jax.nn.sigmoid(fr))
    k = (1.0 - lbh) * jax.nn.sigmoid(-fr)
    v = i_raw.astype(f32).reshape(bsz, t_, HG_HEADS, HG_V)
    o, s = gated_linear_scan(q, k, v, logf, s0.astype(f32))
    g = g_raw.astype(f32).reshape(bsz, t_, HG_HEADS, HG_V)
    o = rms_head(o, gain) * jax.nn.silu(g)
    return o.reshape(bsz, t_, HG_WIDTH), s


def gla_branch(q_raw, k_raw, v_raw, g_raw, gk_lr, w_gk, b_gk, gain, s0):
    bsz, t_, _ = q_raw.shape
    f32 = jnp.float32
    q = q_raw.astype(f32).reshape(bsz, t_, GLA_HEADS, GLA_K) * (GLA_K ** -0.5)
    k = k_raw.astype(f32).reshape(bsz, t_, GLA_HEADS, GLA_K)
    v = v_raw.astype(f32).reshape(bsz, t_, GLA_HEADS, GLA_V)
    gk = gk_lr.astype(f32) @ w_gk.astype(f32) + b_gk.astype(f32)
    logf = (jax.nn.log_sigmoid(gk) / GLA_GATE_NORM).reshape(bsz, t_, GLA_HEADS, GLA_K)
    o, s = gated_linear_scan(q, k, v, logf, s0.astype(f32))
    g = g_raw.astype(f32).reshape(bsz, t_, GLA_HEADS, GLA_V)
    o = rms_head(o, gain) * jax.nn.silu(g)
    return o.reshape(bsz, t_, GLA_VW), s


def decoder_layer(x, p, s_hg, s_gla, lb, ln1, w_in, hg_norm, gla_w_gk, gla_b_gk, gla_norm,
                  w_branch, w_out, ln2, w_gu, w_down, ln3, w_ple, w_pg):
    bsz, t_, _ = x.shape
    h = rmsnorm(x, ln1)
    z = h @ w_in
    splits = [int(c) for c in np.cumsum(IN_SIZES)[:-1]]
    hq, hf, hi, hgt, gq, gk, gv, gg, glr, mg = jnp.split(z, splits, axis=-1)
    a, s_hg = hgrn2_branch(hq, hf, hi, hgt, lb, hg_norm, s_hg)
    b, s_gla = gla_branch(gq, gk, gv, gg, glr, gla_w_gk, gla_b_gk, gla_norm, s_gla)
    br = jnp.stack([a, b], axis=0).astype(x.dtype)
    up = jnp.einsum('nbtw,nwd->nbtd', br, w_branch)
    gates = jax.nn.sigmoid(mg.astype(jnp.float32).reshape(bsz, t_, N_BRANCH, D_MODEL))
    merged = jnp.einsum('btnd,nbtd->btd', gates, up.astype(jnp.float32)).astype(x.dtype)
    x = x + merged @ w_out
    h2 = rmsnorm(x, ln2)
    gate, upv = jnp.split(h2 @ w_gu, 2, axis=-1)
    x = x + (jax.nn.silu(gate) * upv) @ w_down
    h3 = rmsnorm(x, ln3)
    x = x + jax.nn.sigmoid(h3 @ w_pg) * (p.astype(x.dtype) @ w_ple)
    return x, s_hg, s_gla


def setup_inputs(seed: int = 0) -> dict:
    key = jax.random.key(seed)
    ks = jax.random.split(key, 24)
    f32 = jnp.float32
    nrm = lambda k, shape, s: jax.random.normal(k, shape, f32) * s
    gain = lambda k, shape: 1.0 + 0.02 * jax.random.normal(k, shape, f32)
    return {
        "x_prompt": nrm(ks[0], (BATCH, SEQ, D_MODEL), 1.0),
        "x_sample": nrm(ks[1], (DEC_BATCH, DEC_SEQ, D_MODEL), 1.0),
        "state_hgrn": nrm(ks[2], (DEPTH, DEC_BATCH, HG_HEADS, HG_K, HG_V), 0.5),
        "state_gla": nrm(ks[3], (DEPTH, DEC_BATCH, GLA_HEADS, GLA_K, GLA_V), 0.5),
        "p_prompt": nrm(ks[4], (DEPTH, BATCH, SEQ, PLE_DIM), 1.0),
        "p_sample": nrm(ks[5], (DEPTH, DEC_BATCH, DEC_SEQ, PLE_DIM), 1.0),
        "hg_lb": nrm(ks[6], (DEPTH + 1, HG_HEADS * HG_K), 0.1),
        "ln1": gain(ks[7], (DEPTH, D_MODEL)),
        "w_in": nrm(ks[8], (DEPTH, D_MODEL, IN_COLS), D_MODEL ** -0.5),
        "hg_norm": gain(ks[9], (DEPTH, HG_V)),
        "gla_w_gk": nrm(ks[10], (DEPTH, GLA_GATE_RANK, GLA_KW), GLA_GATE_RANK ** -0.5),
        "gla_b_gk": nrm(ks[11], (DEPTH, GLA_KW), 0.1),
        "gla_norm": gain(ks[12], (DEPTH, GLA_V)),
        "w_branch": nrm(ks[13], (DEPTH, N_BRANCH, BRANCH_W, D_MODEL), BRANCH_W ** -0.5),
        "w_out": nrm(ks[14], (DEPTH, D_MODEL, D_MODEL), D_MODEL ** -0.5),
        "ln2": gain(ks[15], (DEPTH, D_MODEL)),
        "w_gu": nrm(ks[16], (DEPTH, D_MODEL, 2 * D_FF), D_MODEL ** -0.5),
        "w_down": nrm(ks[17], (DEPTH, D_FF, D_MODEL), D_FF ** -0.5),
        "ln3": gain(ks[18], (DEPTH, D_MODEL)),
        "w_ple": nrm(ks[19], (DEPTH, PLE_DIM, D_MODEL), PLE_DIM ** -0.5),
        "w_pg": nrm(ks[20], (DEPTH, D_MODEL, D_MODEL), D_MODEL ** -0.5),
        "ln_f": gain(ks[21], (D_MODEL,)),
    }


def reference(x_prompt, x_sample, state_hgrn, state_gla, p_prompt, p_sample, hg_lb, ln1, w_in,
              hg_norm, gla_w_gk, gla_b_gk, gla_norm, w_branch, w_out, ln2, w_gu, w_down, ln3,
              w_ple, w_pg, ln_f):
    lb_all = jnp.cumsum(jax.nn.softmax(hg_lb.astype(jnp.float32), axis=0), axis=0)
    xp, xs = x_prompt, x_sample
    hp_list, gp_list, hs_list, gs_list = [], [], [], []
    for i in range(DEPTH):
        w = (lb_all[i], ln1[i], w_in[i], hg_norm[i], gla_w_gk[i], gla_b_gk[i], gla_norm[i],
             w_branch[i], w_out[i], ln2[i], w_gu[i], w_down[i], ln3[i], w_ple[i], w_pg[i])
        s_hg0 = jnp.zeros((BATCH, HG_HEADS, HG_K, HG_V), jnp.float32)
        s_gl0 = jnp.zeros((BATCH, GLA_HEADS, GLA_K, GLA_V), jnp.float32)
        xp, hp, gp = decoder_layer(xp, p_prompt[i], s_hg0, s_gl0, *w)
        xs, hs, gs = decoder_layer(xs, p_sample[i], state_hgrn[i], state_gla[i], *w)
        hp_list.append(hp.astype(state_hgrn.dtype))
        gp_list.append(gp.astype(state_gla.dtype))
        hs_list.append(hs.astype(state_hgrn.dtype))
        gs_list.append(gs.astype(state_gla.dtype))
    y_prompt = rmsnorm(xp, ln_f)
    y_sample = rmsnorm(xs, ln_f)
    new_hgrn_prompt = jnp.stack(hp_list, axis=0)
    new_gla_prompt = jnp.stack(gp_list, axis=0)
    new_hgrn_sample = jnp.stack(hs_list, axis=0)
    new_gla_sample = jnp.stack(gs_list, axis=0)
    return (y_prompt, y_sample, new_hgrn_prompt, new_gla_prompt, new_hgrn_sample, new_gla_sample)
```

```cpp
#include <hip/hip_runtime.h>
#include <cstdio>
#include <cstdint>

namespace pg8 {
#define PG8_LAS __attribute__((address_space(3)))
typedef unsigned short bf16_t;
typedef short bf16x8 __attribute__((ext_vector_type(8)));
typedef float f32x4 __attribute__((ext_vector_type(4)));
typedef unsigned u32x4 __attribute__((ext_vector_type(4)));
constexpr int BM = 256, BK = 64, HALF = 128, HTB = HALF * BK * 2  , STAGE_BYTES = 8 * HTB, NXCD = 8, WGM = 8;

__host__ __device__ __forceinline__ int lds_byte(int r, int c) { const int st = (r >> 4) * 2 + (c >> 5), rr = r & 15, cc = c & 31, ob = rr * 64 + cc * 2; return st * 1024 + (ob ^ (((ob >> 9) & 1) << 5)); }
__host__ __device__ __forceinline__ void stage_rc(int b, int& R, int& C) { const int st = b / 1024, sb = b % 1024, swz = sb ^ (((sb >> 9) & 1) << 5); R = (st >> 1) * 16 + swz / 64; C = (st & 1) * 32 + (swz % 64) / 2; }
__host__ __device__ __forceinline__ int perm32(int rho) { const int n = rho >> 4, i = rho & 15; return 8 * (i >> 2) + 4 * n + (i & 3); }

struct Unit { int pm, pn, sub; };
struct Gemm { int lda, ldb, nt; };

struct Sched {
    int nM, nN, nwg, G, c, subs;
    const char* A; const char* B; size_t a_tile, b_tile, a_sub, b_sub;
    int remap_from = -1, remap_to = 0, i0 = 0, icount = 1 << 30;
    __device__ __forceinline__ bool next(int i, Unit& u) const {
        if (i >= icount) return false; i += i0;
        const int round = (subs == 2) ? (i >> 1) : i; u.sub = (subs == 2) ? (i & 1) : 0;
        const long L = (long)round * G + c; if (L >= nwg) return false;
        int wgid = (int)L; { const int q = nwg / NXCD, r = nwg % NXCD, xcd = wgid % NXCD, off = wgid / NXCD; wgid = (xcd < r ? xcd * (q + 1) : r * (q + 1) + (xcd - r) * q) + off; }
        const int nig = WGM * nN, gid = wgid / nig, fm = gid * WGM, gsz = (nM - fm) < WGM ? (nM - fm) : WGM;
        u.pm = fm + ((wgid % nig) % gsz); u.pn = (wgid % nig) / gsz; if (u.pn == remap_from) u.pn = remap_to; return true;
    }
    __device__ __forceinline__ void ptrs(const Unit& u, const char*& a, const char*& b) const { a = A + (size_t)u.pm * a_tile + (size_t)u.sub * a_sub; b = B + (size_t)u.pn * b_tile + (size_t)u.sub * b_sub; }
    __device__ __forceinline__ const char* xptr(const Unit& u) const { return A + (size_t)nM * a_tile + (size_t)u.pm * (a_tile >> 4) + (size_t)u.sub * a_sub; }
};
struct SchedList {
    int first, stride, total, nM, pn0;
    const char* A; const char* B; size_t a_tile, b_tile;
    __device__ __forceinline__ bool next(int i, Unit& u) const { const int id = first + stride * i; if (id >= total) return false; u.pm = id % nM; u.pn = pn0 + id / nM; u.sub = 0; return true; }
    __device__ __forceinline__ void ptrs(const Unit& u, const char*& a, const char*& b) const { a = A + (size_t)u.pm * a_tile; b = B + (size_t)u.pn * b_tile; }
    __device__ __forceinline__ const char* xptr(const Unit& u) const { return A + (size_t)nM * a_tile + (size_t)u.pm * (a_tile >> 4); }
};

typedef float f32x2_t __attribute__((ext_vector_type(2))); typedef __bf16 bf16x2_t __attribute__((ext_vector_type(2)));
__device__ __forceinline__ unsigned cvt_pk_bf16(float lo, float hi) { f32x2_t v = {lo, hi}; bf16x2_t b = __builtin_convertvector(v, bf16x2_t); return __builtin_bit_cast(unsigned, b); }
__device__ __forceinline__ float bf_lo(unsigned u) { return __uint_as_float(u << 16); }
__device__ __forceinline__ float bf_hi(unsigned u) { return __uint_as_float(u & 0xffff0000u); }

constexpr int XBUF_OFF = 131072 + 4096;
template <bool EX, class Epi, class SchedT>
__device__ __forceinline__ void gemm_phase_t(PG8_LAS unsigned char* lds, const Gemm g, const SchedT& S, const Epi& E) {
    int tid = threadIdx.x; asm volatile("" : "+v"(tid));
    const int wid = __builtin_amdgcn_readfirstlane(tid >> 6), lane = tid & 63, wr = wid >> 2, wc = wid & 3, fr = lane & 15, fq = lane >> 4;
    int nt = g.nt; asm volatile("" : "+s"(nt));
    unsigned voffA[2], voffB[2];
#pragma unroll
    for (int i = 0; i < 2; ++i) { int R, C; stage_rc(tid * 16 + i * 8192, R, C); const int Rb = (R & ~31) + perm32(R & 31);
        voffA[i] = (unsigned)(R * g.lda + C) * 2u; voffB[i] = (unsigned)(Rb * g.ldb + C) * 2u; }
    const size_t kstep = (size_t)(BK * 2);
    const size_t hstepA = (size_t)HALF * g.lda * 2, hstepB = (size_t)HALF * g.ldb * 2;
    const unsigned ldsw = (unsigned)wid * 1024u;
    const int aoff = lds_byte(wr * 64 + fr, fq * 8), boff = lds_byte(wc * 32 + fr, fq * 8);
    unsigned voffX = 0; const int xoff = XBUF_OFF + lds_byte(fr, fq * 8);
    if constexpr (EX) { int R, C; stage_rc(tid * 4, R, C); voffX = (unsigned)(R * g.lda + C) * 2u; }
#define PG8_STAGEX(b, gbase) do { if constexpr (EX) { const char* gb_ = (const char*)(gbase); asm volatile("" : "+s"(gb_)); __builtin_amdgcn_global_load_lds((const unsigned*)(gb_ + voffX), (PG8_LAS unsigned*)(lds + XBUF_OFF + (b) * 2048 + wid * 256), 4, 0, 0); } } while (0)
#define PG8_MMAX1(Bt) do { _Pragma("unroll") for (int n = 0; n < 2; ++n) _Pragma("unroll") for (int k = 0; k < 2; ++k) ex[n] = __builtin_amdgcn_mfma_f32_16x16x32_bf16(Bt[n][k], At[0][k], ex[n], 0, 0, 0); } while (0)
#define PG8_MMA2X(b) do { __builtin_amdgcn_s_setprio(1); \
        _Pragma("unroll") for (int n = 0; n < 2; ++n) _Pragma("unroll") for (int k = 0; k < 2; ++k) acc[1][1][0][n] = __builtin_amdgcn_mfma_f32_16x16x32_bf16(B1[n][k], At[0][k], acc[1][1][0][n], 0, 0, 0); \
        PG8_SCHED; At[0][0] = *(const PG8_LAS bf16x8*)(lds + xoff + (b) * 2048); At[0][1] = *(const PG8_LAS bf16x8*)(lds + xoff + (b) * 2048 + 1024); PG8_SCHED; \
        _Pragma("unroll") for (int m = 1; m < 4; ++m) _Pragma("unroll") for (int n = 0; n < 2; ++n) _Pragma("unroll") for (int k = 0; k < 2; ++k) acc[1][1][m][n] = __builtin_amdgcn_mfma_f32_16x16x32_bf16(B1[n][k], At[m][k], acc[1][1][m][n], 0, 0, 0); \
        PG8_SCHED; if (wr == 0) PG8_MMAX1(B0); else PG8_MMAX1(B1); __builtin_amdgcn_s_setprio(0); } while (0)
#define PG8_WAIT_VK do { if constexpr (EX) PG8_WAIT_V(9); else PG8_WAIT_V(8); } while (0)
#define PG8_SA(b, h) (((b) * 2 + (h)) * HTB)
#define PG8_SB(b, h) ((4 + (b) * 2 + (h)) * HTB)
#define PG8_STAGE(bufoff, gbase, voff) do { const char* gb_ = (const char*)(gbase); asm volatile("" : "+s"(gb_)); _Pragma("unroll") for (int _i = 0; _i < 2; ++_i) \
        __builtin_amdgcn_global_load_lds((const unsigned*)(gb_ + (voff)[_i]), (PG8_LAS unsigned*)(lds + (bufoff) + ldsw + _i * 8192), 16, 0, 0); } while (0)
#define PG8_LDA(dst, b, h) do { _Pragma("unroll") for (int m = 0; m < 4; ++m) _Pragma("unroll") for (int k = 0; k < 2; ++k) dst[m][k] = *(const PG8_LAS bf16x8*)(lds + PG8_SA(b, h) + aoff + m * 2048 + k * 1024); } while (0)
#define PG8_LDB(dst, b, h) do { _Pragma("unroll") for (int n = 0; n < 2; ++n) _Pragma("unroll") for (int k = 0; k < 2; ++k) dst[n][k] = *(const PG8_LAS bf16x8*)(lds + PG8_SB(b, h) + boff + n * 2048 + k * 1024); } while (0)
#define PG8_MMA(ai, bj, At, Bt) do { __builtin_amdgcn_s_setprio(1); _Pragma("unroll") for (int m = 0; m < 4; ++m) _Pragma("unroll") for (int n = 0; n < 2; ++n) _Pragma("unroll") for (int k = 0; k < 2; ++k) \
        acc[ai][bj][m][n] = __builtin_amdgcn_mfma_f32_16x16x32_bf16(Bt[n][k], At[m][k], acc[ai][bj][m][n], 0, 0, 0); __builtin_amdgcn_s_setprio(0); } while (0)
#define PG8_WAIT_V(n) asm volatile("s_waitcnt vmcnt(" #n ")" ::: "memory")
#define PG8_WAIT_L(n) asm volatile("s_waitcnt lgkmcnt(" #n ")" ::: "memory")
#define PG8_BAR __builtin_amdgcn_s_barrier()
#define PG8_SCHED __builtin_amdgcn_sched_barrier(0)
    Unit cur, nxt; int ui = 0;
    if (!S.next(0, cur)) return;
    f32x4 acc[2][2][4][2];
#pragma unroll
    for (int a = 0; a < 2; ++a)
#pragma unroll
        for (int b = 0; b < 2; ++b)
#pragma unroll
            for (int m = 0; m < 4; ++m)
#pragma unroll
                for (int n = 0; n < 2; ++n) acc[a][b][m][n] = (f32x4){0.f, 0.f, 0.f, 0.f};
    bf16x8 At[4][2], B0[2][2], B1[2][2];
    f32x4 ex[2] = {{0.f, 0.f, 0.f, 0.f}, {0.f, 0.f, 0.f, 0.f}};
    const char* cA; const char* cB; S.ptrs(cur, cA, cB);
    const char* cX = cA; if constexpr (EX) cX = S.xptr(cur);
    PG8_STAGE(PG8_SB(0, 0), cB, voffB); PG8_STAGE(PG8_SB(0, 1), cB + hstepB, voffB); PG8_STAGE(PG8_SA(0, 0), cA, voffA); PG8_STAGE(PG8_SA(0, 1), cA + hstepA, voffA); PG8_STAGEX(0, cX);
    if (wr == 1) PG8_BAR;
    if constexpr (EX) PG8_WAIT_V(3); else PG8_WAIT_V(2);
    PG8_BAR;
    PG8_STAGE(PG8_SB(1, 0), cB + kstep, voffB); PG8_STAGE(PG8_SA(1, 0), cA + kstep, voffA); PG8_STAGE(PG8_SB(1, 1), cB + hstepB + kstep, voffB);
    PG8_WAIT_V(6); PG8_BAR;
    for (;;) {
        const bool has_next = S.next(ui + 1, nxt);
        const char* nA = cA; const char* nB = cB; if (has_next) S.ptrs(nxt, nA, nB);
        const char* nX = cX; if constexpr (EX) { if (has_next) nX = S.xptr(nxt); }
        for (int t = 0; t < nt; t += 2) {
            const bool last = (t == nt - 2);
            const char* a1 = cA + (size_t)(t + 1) * kstep;
            const char* a2 = last ? nA : cA + (size_t)(t + 2) * kstep; const char* b2 = last ? nB : cB + (size_t)(t + 2) * kstep;
            const char* a3 = a2 + kstep; const char* b3 = b2 + kstep;
            const char* x1 = cX + (size_t)(t + 1) * kstep; const char* x2 = last ? nX : cX + (size_t)(t + 2) * kstep;
            PG8_LDB(B0, 0, 0); PG8_LDB(B1, 0, 1); PG8_SCHED; PG8_LDA(At, 0, 0); PG8_STAGE(PG8_SA(1, 1), a1 + hstepA, voffA); if (wr == 1) PG8_STAGEX(1, x1);
            PG8_WAIT_VK; PG8_WAIT_L(0); PG8_BAR; PG8_MMA(0, 0, At, B0); PG8_MMA(0, 1, At, B1); PG8_BAR; PG8_SCHED;
            PG8_LDA(At, 0, 1); PG8_STAGE(PG8_SB(0, 0), b2, voffB); PG8_STAGE(PG8_SB(0, 1), b2 + hstepB, voffB); PG8_STAGE(PG8_SA(0, 0), a2, voffA); if (wr == 0) PG8_STAGEX(1, x1);
            PG8_WAIT_VK; PG8_WAIT_L(0); PG8_BAR; PG8_MMA(1, 0, At, B0); if constexpr (EX) PG8_MMA2X(0); else PG8_MMA(1, 1, At, B1); PG8_BAR; PG8_SCHED;
            PG8_LDB(B0, 1, 0); PG8_LDB(B1, 1, 1); PG8_SCHED; PG8_LDA(At, 1, 0); PG8_STAGE(PG8_SA(0, 1), a2 + hstepA, voffA); if (wr == 1) PG8_STAGEX(0, x2);
            PG8_WAIT_VK; PG8_WAIT_L(0); PG8_BAR; PG8_MMA(0, 0, At, B0); PG8_MMA(0, 1, At, B1); PG8_BAR; PG8_SCHED;
            PG8_LDA(At, 1, 1); PG8_STAGE(PG8_SB(1, 0), b3, voffB); PG8_STAGE(PG8_SB(1, 1), b3 + hstepB, voffB); PG8_STAGE(PG8_SA(1, 0), a3, voffA); if (wr == 0) PG8_STAGEX(0, x2);
            PG8_WAIT_VK; PG8_WAIT_L(0); PG8_BAR; PG8_MMA(1, 0, At, B0); if constexpr (EX) PG8_MMA2X(1); else PG8_MMA(1, 1, At, B1); PG8_BAR; PG8_SCHED;
        }
        if (wr == 0) PG8_BAR;
        bool zero; int efr = fr, efq = fq; asm volatile("" : "+v"(efr), "+v"(efq));
        if constexpr (EX) zero = E(acc, ex, cur, wr, wc, efr, efq); else zero = E(acc, cur, wr, wc, efr, efq);
        if (!has_next) break;
        if (zero) {
#pragma unroll
        for (int a = 0; a < 2; ++a)
#pragma unroll
            for (int b = 0; b < 2; ++b)
#pragma unroll
                for (int m = 0; m < 4; ++m)
#pragma unroll
                    for (int n = 0; n < 2; ++n) acc[a][b][m][n] = (f32x4){0.f, 0.f, 0.f, 0.f};
            ex[0] = (f32x4){0.f, 0.f, 0.f, 0.f}; ex[1] = (f32x4){0.f, 0.f, 0.f, 0.f};
        }
        cur = nxt; cA = nA; cB = nB; cX = nX; ++ui;
        if (wr == 1) PG8_BAR;
    }
    PG8_WAIT_V(0);
    PG8_BAR;
#undef PG8_SA
#undef PG8_SB
#undef PG8_STAGE
#undef PG8_STAGEX
#undef PG8_MMAX1
#undef PG8_MMA2X
#undef PG8_WAIT_VK
#undef PG8_LDA
#undef PG8_LDB
#undef PG8_MMA
#undef PG8_WAIT_V
#undef PG8_WAIT_L
#undef PG8_BAR
#undef PG8_SCHED
}
template <class Epi, class SchedT>
__device__ __forceinline__ void gemm_phase(PG8_LAS unsigned char* lds, const Gemm g, const SchedT& S, const Epi& E) { gemm_phase_t<false>(lds, g, S, E); }
}

constexpr int NWAVES = 8;
constexpr int DM = 2048, NPROMPT = 8192, NSAMPLE = 512, MTOT = NPROMPT + NSAMPLE;
constexpr int SEQ = 2048, DECB = 128, DECS = 4, PLE = 256, DFF = 5632;
constexpr int HGH = 8, GLH = 4;
constexpr int INCOLS = 11280, LDZ = 11264, N1PAD = 11520;
constexpr int ZC_HQ = 0, ZC_HK = 1024, ZC_HV = 2048, ZC_HG = 3072, ZC_GQ = 4096, ZC_GK = 4608, ZC_GV = 5120, ZC_GG = 6144, ZC_MG = 7168;
constexpr float EPS = 1e-6f, SQK = 0.08838834764831845f;

constexpr size_t MiB = 1u << 20;
constexpr size_t WS_CTL = 0, CTL_ZERO_BYTES = 256 * 1024;
constexpr size_t WS_WIN = 2 * MiB, WS_WB = 47 * MiB, WS_WOUT = 55 * MiB, WS_WGU = 63 * MiB, WS_WDN = 107 * MiB, WS_WPG = 129 * MiB, WS_WPLE = 137 * MiB;
constexpr size_t WS_PB = 138 * MiB;
constexpr size_t WS_RSTD1 = 143 * MiB, WS_GLR = WS_RSTD1 + 64 * 1024, WS_SS2 = 144 * MiB, WS_SS3 = WS_SS2 + 1280 * 1024, WS_SSF = WS_SS3 + 1280 * 1024;
constexpr size_t WS_SSFX = WS_SSF + 1152 * 1024;
constexpr size_t WS_BUFA = 148 * MiB, WS_BUFB = 182 * MiB;
constexpr size_t WS_LOGF = 216 * MiB;
constexpr size_t WS_Z = 250 * MiB;
constexpr size_t WS_PLEF = WS_LOGF;
constexpr size_t WS_AD = 437 * MiB;
constexpr size_t WS_END = 447 * MiB;
static_assert(WS_WIN + (size_t)N1PAD * DM * 2 <= WS_WB && WS_WGU + (size_t)2 * DFF * DM * 2 <= WS_WDN && WS_WDN + (size_t)DM * DFF * 2 <= WS_WPG && WS_PB + (size_t)MTOT * PLE * 2 <= WS_RSTD1, "ws map 1");
static_assert(WS_GLR + (size_t)MTOT * 16 * 4 <= WS_SS2 && WS_SSF + (size_t)MTOT * 32 * 4 <= WS_SSFX && WS_SSFX + (size_t)8 * NSAMPLE * 8 * 4 <= WS_BUFA && WS_BUFA + (size_t)MTOT * DM * 2 <= WS_BUFB && WS_BUFB + (size_t)MTOT * DM * 2 <= WS_LOGF, "ws map 2");
static_assert(WS_LOGF + (size_t)MTOT * 1024 * 4 <= WS_Z && WS_Z + (size_t)MTOT * LDZ * 2 <= WS_END && (size_t)MTOT * DFF * 2 <= 96 * MiB && WS_PLEF + (size_t)MTOT * DM * 2 <= WS_Z, "ws map 3");
constexpr size_t OUT_Y = 0, OUT_HP = (size_t)MTOT * DM, OUT_GP = OUT_HP + 4 * 8 * 128 * 128, OUT_HS = OUT_GP + 4 * 4 * 128 * 256, OUT_GS = OUT_HS + (size_t)128 * 8 * 128 * 128, OUT_END = OUT_GS + (size_t)128 * 4 * 128 * 256;
constexpr int CW_PSUB = 2048;
constexpr int CW_XCC = 1024;
constexpr int CW_PRE = 512;
constexpr int CW_Q = 64;
constexpr int CW_BAR = 4096;
constexpr int CW_PB3 = 12288, CW_PB6 = 16384;
constexpr int CW_PAN = 8192;

constexpr int RING_OFF = 0, RING_BYTES = 131072;
constexpr int LDSCTL_OFF = RING_BYTES, MISC_OFF = LDSCTL_OFF + 320;
constexpr int XS_OFF = pg8::XBUF_OFF + 4096;
constexpr int LDS_BYTES = 147456;

#define GAS __attribute__((address_space(1)))
#define LAS __attribute__((address_space(3)))
typedef unsigned short bf16;
typedef unsigned v4u __attribute__((ext_vector_type(4)));
typedef unsigned v2u __attribute__((ext_vector_type(2)));
typedef float f32x4 __attribute__((ext_vector_type(4)));
typedef short bf16x8 __attribute__((ext_vector_type(8)));
typedef short s16x4 __attribute__((ext_vector_type(4)));
typedef GAS unsigned gu32;
#define RLX_AGENT __ATOMIC_RELAXED, __HIP_MEMORY_SCOPE_AGENT
#define LDS_WAIT() asm volatile("s_waitcnt lgkmcnt(0)" ::: "memory")
#define VM_WAIT() asm volatile("s_waitcnt vmcnt(0)" ::: "memory")
__device__ __forceinline__ unsigned f2bf(float f) { unsigned u = __builtin_bit_cast(unsigned, f); return (u + 0x7fffu + ((u >> 16) & 1u)) >> 16; }
__device__ __forceinline__ unsigned pk2(float lo, float hi) { return f2bf(lo) | (f2bf(hi) << 16); }
__device__ __forceinline__ float bf2f(bf16 b) { return __uint_as_float((unsigned)b << 16); }
__device__ __forceinline__ float sigm(float v) { return __builtin_amdgcn_rcpf(1.f + __expf(-v)); }

#define XB_TMO      128
#define XB_XCNT(j)  (256  + 64 * (j))
#define XB_XSUB(j)  (1280 + 64 * (j))
#define XB_XGEN(j)  (2304 + 64 * (j))
#define XB_TOP      3328
#define XB_TOPGEN   3392
#define XCD_BAR_WORDS 3456
#define XB_SPIN_CAP (1u << 18)
__device__ __forceinline__ unsigned xb_ld(unsigned* p)              { return __hip_atomic_load(p, __ATOMIC_RELAXED, __HIP_MEMORY_SCOPE_AGENT); }
__device__ __forceinline__ unsigned xb_add(unsigned* p, unsigned v) { return __hip_atomic_fetch_add(p, v, __ATOMIC_RELAXED, __HIP_MEMORY_SCOPE_AGENT); }
__device__ __forceinline__ unsigned xb_xcc_id() { return (unsigned)__builtin_amdgcn_s_getreg((3 << 11) | 20) & 0xFu; }
#define XB_SPIN(cond, bar) do { unsigned _sp = 0; while (cond) { __builtin_amdgcn_s_sleep(1); \
    if ((++_sp & 255u) == 0u) { if (xb_ld(&(bar)[XB_TMO])) break; if (_sp > XB_SPIN_CAP) { atomicAdd(&(bar)[XB_TMO], 1u); break; } } } } while (0)
struct XcdBarrier { unsigned* bar; unsigned x; volatile LAS unsigned* st; };
__device__ __forceinline__ XcdBarrier xcd_barrier_post(unsigned* bar, volatile LAS unsigned* st) {
    XcdBarrier b; b.bar = bar; b.x = xb_xcc_id(); b.st = st;
    if (threadIdx.x == 0) (void)xb_add(&bar[XB_XCNT(b.x)], 1u);
    return b;
}
__device__ __forceinline__ void xcd_barrier_complete(unsigned* bar, unsigned x, unsigned& nloc, unsigned& nx) {
    const unsigned G = gridDim.x * gridDim.y * gridDim.z;
    unsigned sum, cnt, mine, sp = 0u;
    for (;;) {
        sum = 0u; cnt = 0u; mine = 0u;
#pragma unroll
        for (unsigned j = 0; j < 16; ++j) { const unsigned c = xb_ld(&bar[XB_XCNT(j)]); sum += c; cnt += (c > 0u) ? 1u : 0u; mine = (j == x) ? c : mine; }
        if (sum == G) break;
        __builtin_amdgcn_s_sleep(1);
        if ((++sp & 255u) == 0u) { if (xb_ld(&bar[XB_TMO])) break; if (sp > XB_SPIN_CAP) { atomicAdd(&bar[XB_TMO], 1u); break; } }
    }
    nloc = mine > 0u ? mine : 1u; nx = cnt > 0u ? cnt : 1u;
}
__device__ __forceinline__ void xcd_barrier(const XcdBarrier& b) {
    asm volatile("s_waitcnt vmcnt(0)" ::: "memory");
    __syncthreads();
    if (threadIdx.x == 0) {
        unsigned* bar = b.bar;
        __builtin_amdgcn_s_waitcnt(0);
        unsigned nloc = b.st[0], nx = b.st[1];
        if (nloc == 0u) { xcd_barrier_complete(bar, b.x, nloc, nx); b.st[0] = nloc; b.st[1] = nx; }
        const unsigned old = xb_add(&bar[XB_XSUB(b.x)], 1u);
        const unsigned gen = old / nloc;
        if (old + 1u == (gen + 1u) * nloc) {
            __builtin_amdgcn_fence(__ATOMIC_RELEASE, "agent");
            asm volatile("s_waitcnt vmcnt(0)" ::: "memory");
            const unsigned og = xb_add(&bar[XB_TOP], 1u);
            const unsigned tg = og / nx;
            if (og + 1u == (tg + 1u) * nx) xb_add(&bar[XB_TOPGEN], 1u);
            else XB_SPIN(xb_ld(&bar[XB_TOPGEN]) == tg, bar);
            __builtin_amdgcn_fence(__ATOMIC_ACQUIRE, "agent");
            xb_add(&bar[XB_XGEN(b.x)], 1u);
            asm volatile("s_waitcnt vmcnt(0)" ::: "memory");
        } else {
            XB_SPIN(xb_ld(&bar[XB_XGEN(b.x)]) == gen, bar);
            __builtin_amdgcn_fence(__ATOMIC_ACQUIRE, "agent");
            asm volatile("s_waitcnt vmcnt(0)" ::: "memory");
        }
    }
    __syncthreads();
}

__device__ __forceinline__ void grid_barrier(gu32* w, unsigned epoch, int G, int bx, int xcc = -1) {
    asm volatile("s_waitcnt vmcnt(0)" ::: "memory");
    __syncthreads();
    if (threadIdx.x == 0) {
        if (xcc < 0) { __builtin_amdgcn_fence(__ATOMIC_RELEASE, "agent"); asm volatile("s_waitcnt vmcnt(0)" ::: "memory"); }
        const bool two = (G % 8) == 0; const int g = two ? (xcc >= 0 ? xcc : (bx & 7)) : 0; const unsigned nloc = two ? (unsigned)(G / 8) : (unsigned)G, ngrp = two ? 8u : 1u;
        gu32* sub = w + 64 * g; gu32* gen = w + 64 * (8 + g); gu32* top = w + 64 * 16; gu32* topgen = w + 64 * 17;
        unsigned sp = 0;
        if (__hip_atomic_fetch_add(sub, 1u, RLX_AGENT) + 1u == epoch * nloc) {
            if (xcc >= 0) { __builtin_amdgcn_fence(__ATOMIC_RELEASE, "agent"); asm volatile("s_waitcnt vmcnt(0)" ::: "memory"); }
            if (__hip_atomic_fetch_add(top, 1u, RLX_AGENT) + 1u == epoch * ngrp) __hip_atomic_fetch_add(topgen, 1u, RLX_AGENT);
            else while (__hip_atomic_load(topgen, RLX_AGENT) < epoch && ++sp < (1u << 24)) __builtin_amdgcn_s_sleep(2);
            __hip_atomic_fetch_add(gen, 1u, RLX_AGENT);
        } else while (__hip_atomic_load(gen, RLX_AGENT) < epoch && ++sp < (1u << 24)) __builtin_amdgcn_s_sleep(4);
        __builtin_amdgcn_fence(__ATOMIC_ACQUIRE, "agent");
        asm volatile("s_waitcnt vmcnt(0)" ::: "memory");
    }
    __syncthreads();
}

__device__ __forceinline__ void panel_barrier(gu32* c, unsigned n, bool release = true) {
    asm volatile("s_waitcnt vmcnt(0)" ::: "memory");
    __syncthreads();
    if (threadIdx.x == 0) {
        if (release) { __builtin_amdgcn_fence(__ATOMIC_RELEASE, "agent"); asm volatile("s_waitcnt vmcnt(0)" ::: "memory"); }
        unsigned sp = 0;
        if (__hip_atomic_fetch_add(c, 1u, RLX_AGENT) + 1u < n) while (__hip_atomic_load(c, RLX_AGENT) < n && ++sp < (1u << 24)) __builtin_amdgcn_s_sleep(2);
        __builtin_amdgcn_fence(__ATOMIC_ACQUIRE, "agent");
        asm volatile("s_waitcnt vmcnt(0)" ::: "memory");
    }
    __syncthreads();
}

__device__ __forceinline__ void cnt_arrive(gu32* c) {
    asm volatile("s_waitcnt vmcnt(0)" ::: "memory");
    __syncthreads();
    if (threadIdx.x == 0) { __builtin_amdgcn_fence(__ATOMIC_RELEASE, "agent"); asm volatile("s_waitcnt vmcnt(0)" ::: "memory"); __hip_atomic_fetch_add(c, 1u, RLX_AGENT); }
}
__device__ __forceinline__ void cnt_arrive_x(gu32* c, gu32* sub, int xcc, unsigned nloc) {
    if (xcc < 0) { cnt_arrive(c); return; }
    asm volatile("s_waitcnt vmcnt(0)" ::: "memory");
    __syncthreads();
    if (threadIdx.x == 0 && __hip_atomic_fetch_add(sub + 64 * xcc, 1u, RLX_AGENT) + 1u == nloc) {
        __builtin_amdgcn_fence(__ATOMIC_RELEASE, "agent"); asm volatile("s_waitcnt vmcnt(0)" ::: "memory"); __hip_atomic_fetch_add(c, 1u, RLX_AGENT); }
}
__device__ __forceinline__ void cnt_wait(gu32* c, unsigned n) {
    if (threadIdx.x == 0) { unsigned sp = 0;
        while (__hip_atomic_load(c, RLX_AGENT) < n && ++sp < (1u << 24)) __builtin_amdgcn_s_sleep(2);
        __builtin_amdgcn_fence(__ATOMIC_ACQUIRE, "agent"); asm volatile("s_waitcnt vmcnt(0)" ::: "memory"); }
    __syncthreads();
}

__device__ __forceinline__ float wave_sum(float v) {
#pragma unroll
    for (int o = 1; o < 64; o <<= 1) v += __shfl_xor(v, o);
    return v;
}
template <int MODE> __device__ __forceinline__ int dest_row(int n) {
    if (MODE == 1) return n < 7168 ? n : (n < 7184 ? n + 4096 : n - 16);
    if (MODE == 2) { const int up = n >= DFF ? 1 : 0, j = n - up * DFF; return 256 * (j >> 7) + 128 * up + (j & 127); }
    return n;
}
template <int MODE> __device__ __forceinline__ void p0_transpose_item(const float* W, int K, int N, const float* kscale, bf16* WT, LAS float* scr, int item, int lane) {
    const int nblk = (N + 31) / 32, kb = item / nblk, nb = item % nblk, k0 = 64 * kb, n0 = 32 * nb;
    const int nl = n0 + (lane & 31); const bool nok = nl < N;
#pragma unroll 8
    for (int i = 0; i < 32; ++i) { const int kk = 2 * i + (lane >> 5); float v = nok ? W[(size_t)(k0 + kk) * N + nl] : 0.f; if (kscale) v *= kscale[k0 + kk]; scr[kk * 33 + (lane & 31)] = v; }
    LDS_WAIT(); asm volatile("" ::: "memory");
    const int c = lane & 7;
#pragma unroll
    for (int j = 0; j < 4; ++j) { const int n = (lane >> 3) + 8 * j; const LAS float* s = scr + (8 * c) * 33 + n;
        v4u o; o.x = pk2(s[0 * 33], s[1 * 33]); o.y = pk2(s[2 * 33], s[3 * 33]); o.z = pk2(s[4 * 33], s[5 * 33]); o.w = pk2(s[6 * 33], s[7 * 33]);
        if (n0 + n < N) *(GAS v4u*)(WT + (size_t)dest_row<MODE>(n0 + n) * K + k0 + 8 * c) = o; }
    LDS_WAIT(); asm volatile("" ::: "memory");
}

struct P0Mat { const float* W; const float* kscale; bf16* WT; int K, N, mode, tiles; };
__device__ __forceinline__ int dest_row_rt(int mode, int n) { return mode == 1 ? dest_row<1>(n) : (mode == 2 ? dest_row<2>(n) : n); }
__device__ __forceinline__ void p0_tile_load(const P0Mat& m, int tile, f32x4 (&v)[8], int tid) {
    const int ntn = (m.N + 255) >> 8, kb = tile / ntn, nb = tile - kb * ntn, k0 = 64 * kb, n0 = 256 * nb;
#pragma unroll
    for (int i = 0; i < 4; ++i) { const int idx = tid + 512 * i, rp = idx >> 6, n = n0 + 4 * (idx & 63); const float* p = m.W + (size_t)(k0 + 2 * rp) * m.N + n;
        if (n < m.N) { v[2 * i] = *(const GAS f32x4*)p; v[2 * i + 1] = *(const GAS f32x4*)(p + m.N); } else { v[2 * i] = (f32x4){0.f, 0.f, 0.f, 0.f}; v[2 * i + 1] = v[2 * i]; } }
}
__device__ __forceinline__ void p0_tile_store(const P0Mat& m, int tile, const f32x4 (&v)[8], LAS unsigned* img, int tid) {
    const int ntn = (m.N + 255) >> 8, kb = tile / ntn, nb = tile - kb * ntn, k0 = 64 * kb, n0 = 256 * nb;
#pragma unroll
    for (int i = 0; i < 4; ++i) { const int idx = tid + 512 * i, rp = idx >> 6, c4 = idx & 63;
        const float s0 = m.kscale ? m.kscale[k0 + 2 * rp] : 1.f, s1 = m.kscale ? m.kscale[k0 + 2 * rp + 1] : 1.f;
#pragma unroll
        for (int j = 0; j < 4; ++j) img[(4 * c4 + j) * 33 + rp] = pg8::cvt_pk_bf16(v[2 * i][j] * s0, v[2 * i + 1][j] * s1); }
    __syncthreads();
#pragma unroll
    for (int i = 0; i < 4; ++i) { const int idx = tid + 512 * i, n = idx >> 3, c = idx & 7; const LAS unsigned* q = img + n * 33 + 4 * c;
        const v4u o = (v4u){q[0], q[1], q[2], q[3]};
        if (n0 + n < m.N) *(GAS v4u*)(m.WT + (size_t)dest_row_rt(m.mode, n0 + n) * m.K + k0 + 8 * c) = o; }
    __syncthreads();
}

namespace epi {
using pg8::Unit; using pg8::cvt_pk_bf16; using pg8::bf_lo; using pg8::bf_hi;
typedef pg8::f32x4 f4; typedef pg8::u32x4 u4;
#define EPI_ROWS for (int ai = 0; ai < 2; ++ai) _Pragma("unroll") for (int m = 0; m < 4; ++m)
template <int T> __device__ __forceinline__ float act1(float v) {
    if (T == 2) return v;
    if (T == 4) return v * SQK;
    const float s = sigm(v);
    if (T == 0) return v * s * SQK;
    if (T == 3) return v * s;
    return s;
}
__device__ __forceinline__ __amdgpu_buffer_rsrc_t wt_rsrc(const void* base, size_t bytes) { return __builtin_amdgcn_make_buffer_rsrc((void*)base, (short)0, (int)bytes, 0x00020000); }
__device__ __forceinline__ void wt_store16(const __amdgpu_buffer_rsrc_t r, size_t elem_off_bf16, const u4& v) { __builtin_amdgcn_raw_buffer_store_b128(v, r, (unsigned)(elem_off_bf16 * 2), 0,   16); }
__device__ __forceinline__ u4 pack8(const f4& a, const f4& b) { u4 w; w.x = cvt_pk_bf16(a[0], a[1]); w.y = cvt_pk_bf16(a[2], a[3]); w.z = cvt_pk_bf16(b[0], b[1]); w.w = cvt_pk_bf16(b[2], b[3]); return w; }
struct Epi1 {
    bf16* Z; float* LOGF; float* GLR; const float* rstd; const float* hg_lb;
    template <int T> __device__ __forceinline__ void plain(const f4 (&acc)[2][2][4][2], int row0, int col0) const {
#pragma unroll
        EPI_ROWS { const int row = row0 + ai * 128 + m * 16; const float rs = rstd[row];
#pragma unroll
            for (int bj = 0; bj < 2; ++bj) { f4 a = acc[ai][bj][m][0] * rs, b = acc[ai][bj][m][1] * rs;
#pragma unroll
                for (int i = 0; i < 4; ++i) { a[i] = act1<T>(a[i]); b[i] = act1<T>(b[i]); }
                *(u4*)(Z + (size_t)row * LDZ + col0 + bj * 128) = pack8(a, b); } }
    }
    __device__ __forceinline__ bool operator()(f4 (&acc)[2][2][4][2], const Unit& u, int wr, int wc, int fr, int fq) const {
        const int pn = u.pn, row0 = u.pm * 256 + wr * 64 + fr, col0 = pn * 256 + wc * 32 + 8 * fq;
        if (pn < 4) plain<0>(acc, row0, col0);
        else if (pn < 8) {
            float lb[2][8];
#pragma unroll
            for (int bj = 0; bj < 2; ++bj)
#pragma unroll
                for (int i = 0; i < 8; ++i) { const int c = col0 - ZC_HK + bj * 128 + i; lb[bj][i] = __builtin_amdgcn_rcpf(1.f + __expf(hg_lb[1024 + c] - hg_lb[c])); }
#pragma unroll
            EPI_ROWS { const int row = row0 + ai * 128 + m * 16; const float rs = rstd[row];
#pragma unroll
                for (int bj = 0; bj < 2; ++bj) { f4 lf[2], kk[2];
#pragma unroll
                    for (int n = 0; n < 2; ++n)
#pragma unroll
                        for (int i = 0; i < 4; ++i) { const float z = fminf(fmaxf(acc[ai][bj][m][n][i] * rs, -80.f), 80.f), e = __expf(-z), r = __builtin_amdgcn_rcpf(1.f + e);
                            const float l = lb[bj][4 * n + i], om = 1.f - l; lf[n][i] = __logf(l + om * r); kk[n][i] = om * (e * r); }
                    const int c = col0 + bj * 128;
                    *(u4*)(Z + (size_t)row * LDZ + c) = pack8(kk[0], kk[1]);
                    float* lp = LOGF + (size_t)row * 1024 + (c - ZC_HK); *(f4*)lp = lf[0]; *(f4*)(lp + 4) = lf[1]; } }
        }
        else if (pn < 12) plain<2>(acc, row0, col0);
        else if (pn < 16) plain<3>(acc, row0, col0);
        else if (pn < 18) plain<4>(acc, row0, col0);
        else if (pn < 24) plain<2>(acc, row0, col0);
        else if (pn < 28) plain<3>(acc, row0, col0);
        else if (pn < 44) plain<5>(acc, row0, col0);
        else if (wc == 0 && fq < 2) {
#pragma unroll
            EPI_ROWS { const int row = row0 + ai * 128 + m * 16; const float rs = rstd[row]; float* gp = GLR + (size_t)row * 16 + 8 * fq;
                *(f4*)gp = acc[ai][0][m][0] * rs; *(f4*)(gp + 4) = acc[ai][0][m][1] * rs; }
        }
        return true;
    }
};
struct Epi2 {
    const bf16* Z; bf16* MG;
    __device__ __forceinline__ bool operator()(f4 (&acc)[2][2][4][2], const Unit& u, int wr, int wc, int fr, int fq) const {
        const int row0 = u.pm * 256 + wr * 64 + fr, col0 = u.pn * 256 + wc * 32 + 8 * fq;
        const __amdgpu_buffer_rsrc_t mgr = wt_rsrc(MG, (size_t)MTOT * DM * 2);
#pragma unroll
        EPI_ROWS { const int row = row0 + ai * 128 + m * 16;
#pragma unroll
            for (int bj = 0; bj < 2; ++bj) { const int c = col0 + bj * 128; const bf16* gp = Z + (size_t)row * LDZ + ZC_MG + c;
                const u4 g1 = *(const u4*)(gp + DM);
                f4 h0 = (f4){bf_lo(g1.x), bf_hi(g1.x), bf_lo(g1.y), bf_hi(g1.y)}, h1 = (f4){bf_lo(g1.z), bf_hi(g1.z), bf_lo(g1.w), bf_hi(g1.w)};
                if (u.sub == 0) { const u4 g0 = *(const u4*)gp;
                    const f4 q0 = (f4){bf_lo(g0.x), bf_hi(g0.x), bf_lo(g0.y), bf_hi(g0.y)}, q1 = (f4){bf_lo(g0.z), bf_hi(g0.z), bf_lo(g0.w), bf_hi(g0.w)};
#pragma unroll
                    for (int i = 0; i < 4; ++i) { acc[ai][bj][m][0][i] *= q0[i] * __builtin_amdgcn_rcpf(h0[i]); acc[ai][bj][m][1][i] *= q1[i] * __builtin_amdgcn_rcpf(h1[i]); }
                } else wt_store16(mgr, (size_t)row * DM + c, pack8(acc[ai][bj][m][0] * h0, acc[ai][bj][m][1] * h1));
            } }
        return u.sub != 0;
    }
    __device__ __forceinline__ bool operator()(f4 (&acc)[2][2][4][2], f4 (&ex)[2], const Unit& u, int wr, int wc, int fr, int fq) const {
        { const int row = NPROMPT + 16 * u.pm + fr, c = u.pn * 256 + wr * 128 + wc * 32 + 8 * fq; const bf16* gp = Z + (size_t)row * LDZ + ZC_MG + c;
          const u4 g1 = *(const u4*)(gp + DM);
          f4 h0 = (f4){bf_lo(g1.x), bf_hi(g1.x), bf_lo(g1.y), bf_hi(g1.y)}, h1 = (f4){bf_lo(g1.z), bf_hi(g1.z), bf_lo(g1.w), bf_hi(g1.w)};
          if (u.sub == 0) { const u4 g0 = *(const u4*)gp;
              const f4 q0 = (f4){bf_lo(g0.x), bf_hi(g0.x), bf_lo(g0.y), bf_hi(g0.y)}, q1 = (f4){bf_lo(g0.z), bf_hi(g0.z), bf_lo(g0.w), bf_hi(g0.w)};
#pragma unroll
              for (int i = 0; i < 4; ++i) { ex[0][i] *= q0[i] * __builtin_amdgcn_rcpf(h0[i]); ex[1][i] *= q1[i] * __builtin_amdgcn_rcpf(h1[i]); }
          } else wt_store16(wt_rsrc(MG, (size_t)MTOT * DM * 2), (size_t)row * DM + c, pack8(ex[0] * h0, ex[1] * h1)); }
        return (*this)(acc, u, wr, wc, fr, fq);
    }
};
template <bool RES_BF16> struct EpiRes {
    const float* res_p; const float* res_s; const bf16* res_b; bf16* XB; float* SS;
    __device__ __forceinline__ bool operator()(f4 (&acc)[2][2][4][2], const Unit& u, int wr, int wc, int fr, int fq) const {
        const int row0 = u.pm * 256 + wr * 64 + fr, col0 = u.pn * 256 + wc * 32 + 8 * fq;
        const float* rb = u.pm < 32 ? res_p : res_s - (size_t)NPROMPT * DM;
        const __amdgpu_buffer_rsrc_t xbr = wt_rsrc(XB, (size_t)MTOT * DM * 2);
#pragma unroll
        EPI_ROWS { const int row = row0 + ai * 128 + m * 16; float ssq = 0.f;
#pragma unroll
            for (int bj = 0; bj < 2; ++bj) { const size_t off = (size_t)row * DM + col0 + bj * 128;
                f4 r0, r1;
                if (RES_BF16) { const u4 w = *(const u4*)(res_b + off); r0 = (f4){bf_lo(w.x), bf_hi(w.x), bf_lo(w.y), bf_hi(w.y)}; r1 = (f4){bf_lo(w.z), bf_hi(w.z), bf_lo(w.w), bf_hi(w.w)}; }
                else { r0 = *(const f4*)(rb + off); r1 = *(const f4*)(rb + off + 4); }
                const f4 o0 = acc[ai][bj][m][0] + r0, o1 = acc[ai][bj][m][1] + r1;
                wt_store16(xbr, off, pack8(o0, o1));
                ssq += (o0[0] * o0[0] + o0[1] * o0[1]) + (o0[2] * o0[2] + o0[3] * o0[3]) + (o1[0] * o1[0] + o1[1] * o1[1]) + (o1[2] * o1[2] + o1[3] * o1[3]); }
            ssq += __shfl_xor(ssq, 16); ssq += __shfl_xor(ssq, 32);
            if (fq == 0) __hip_atomic_store((unsigned*)(SS + ((size_t)u.pn * MTOT + row) * 4 + wc), __float_as_uint(ssq), __ATOMIC_RELAXED, __HIP_MEMORY_SCOPE_AGENT); }
        return true;
    }
    LAS float* xs;
    __device__ __forceinline__ bool operator()(f4 (&acc)[2][2][4][2], f4 (&ex)[2], const Unit& u, int wr, int wc, int fr, int fq) const {
        const int row = NPROMPT + 16 * u.pm + fr; const size_t off = (size_t)row * DM + u.pn * 256 + wr * 128 + wc * 32 + 8 * fq;
        f4 r0, r1;
        if (RES_BF16) { const u4 w = *(const u4*)(res_b + off); r0 = (f4){bf_lo(w.x), bf_hi(w.x), bf_lo(w.y), bf_hi(w.y)}; r1 = (f4){bf_lo(w.z), bf_hi(w.z), bf_lo(w.w), bf_hi(w.w)}; }
        else { const float* rp = res_s + (off - (size_t)NPROMPT * DM); r0 = *(const f4*)rp; r1 = *(const f4*)(rp + 4); }
        const f4 o0 = ex[0] + r0, o1 = ex[1] + r1;
        wt_store16(wt_rsrc(XB, (size_t)MTOT * DM * 2), off, pack8(o0, o1));
        float sx = (o0[0] * o0[0] + o0[1] * o0[1]) + (o0[2] * o0[2] + o0[3] * o0[3]) + (o1[0] * o1[0] + o1[1] * o1[1]) + (o1[2] * o1[2] + o1[3] * o1[3]);
        sx += __shfl_xor(sx, 16); sx += __shfl_xor(sx, 32);
        if (wr == 1 && fq == 0) xs[wc * 16 + fr] = sx;
        asm volatile("s_waitcnt lgkmcnt(0)" ::: "memory"); __builtin_amdgcn_s_barrier(); asm volatile("" ::: "memory");
        if (wr == 0 && fq == 0) __hip_atomic_store((unsigned*)(SS + ((size_t)u.pn * MTOT + row) * 4 + wc), __float_as_uint(sx + xs[wc * 16 + fr]), __ATOMIC_RELAXED, __HIP_MEMORY_SCOPE_AGENT);
        return (*this)(acc, u, wr, wc, fr, fq);
    }
};
__device__ __forceinline__ float row_rstd(const float* SS, int row, int fq) {
    const f4 a = *(const f4*)(SS + ((size_t)(2 * fq) * MTOT + row) * 4), b = *(const f4*)(SS + ((size_t)(2 * fq + 1) * MTOT + row) * 4);
    float s = ((a[0] + a[1]) + (a[2] + a[3])) + ((b[0] + b[1]) + (b[2] + b[3]));
    s += __shfl_xor(s, 16); s += __shfl_xor(s, 32);
    return __builtin_amdgcn_rsqf(s * (1.f / DM) + EPS);
}
struct EpiPle {
    bf16* PLEF;
    __device__ __forceinline__ bool operator()(f4 (&acc)[2][2][4][2], const Unit& u, int wr, int wc, int fr, int fq) const {
        const int row0 = u.pm * 256 + wr * 64 + fr, col0 = u.pn * 256 + wc * 32 + 8 * fq;
#pragma unroll
        EPI_ROWS { const int row = row0 + ai * 128 + m * 16;
#pragma unroll
            for (int bj = 0; bj < 2; ++bj) { *(u4*)(PLEF + (size_t)row * (2 * DM) + u.pn * 512 + (col0 - u.pn * 256) + bj * 128) = pack8(acc[ai][bj][m][0], acc[ai][bj][m][1]); asm volatile("" ::: "memory"); } }
        return true;
    }
    __device__ __forceinline__ bool operator()(f4 (&acc)[2][2][4][2], f4 (&ex)[2], const Unit& u, int wr, int wc, int fr, int fq) const {
        *(u4*)(PLEF + (size_t)(NPROMPT + 16 * u.pm + fr) * (2 * DM) + u.pn * 512 + wr * 128 + wc * 32 + 8 * fq) = pack8(ex[0], ex[1]); asm volatile("" ::: "memory");
        return (*this)(acc, u, wr, wc, fr, fq);
    }
};
struct Epi4 {
    const float* SS; bf16* ACT;
    __device__ __forceinline__ bool operator()(f4 (&acc)[2][2][4][2], const Unit& u, int wr, int wc, int fr, int fq) const {
        const int row0 = u.pm * 256 + wr * 64 + fr, col0 = u.pn * 128 + wc * 32 + 8 * fq;
#pragma unroll
        EPI_ROWS { const int row = row0 + ai * 128 + m * 16; const float rs = row_rstd(SS, row, fq); f4 o[2];
#pragma unroll
            for (int n = 0; n < 2; ++n)
#pragma unroll
                for (int i = 0; i < 4; ++i) { const float gt = acc[ai][0][m][n][i] * rs, up = acc[ai][1][m][n][i] * rs; o[n][i] = gt * sigm(gt) * up; }
            *(u4*)(ACT + (size_t)row * DFF + col0) = pack8(o[0], o[1]); }
        return true;
    }
};
struct Epi6 {
    const float* SS; const bf16* PLEF; const bf16* XB; float* XR; float* SSF; float* SSFX; const float* lnf; unsigned* cnt;
    __device__ __forceinline__ bool operator()(f4 (&acc)[2][2][4][2], f4 (&ex)[2], const Unit& u, int wr, int wc, int fr, int fq) const {
        const int row0 = u.pm * 256 + wr * 64 + fr, col0 = u.pn * 256 + wc * 32 + 8 * fq;
        const int rowx = NPROMPT + 16 * u.pm + fr, colx = u.pn * 256 + wr * 128 + wc * 32 + 8 * fq;
#pragma unroll
        EPI_ROWS { const int row = row0 + ai * 128 + m * 16; const float rs = row_rstd(SS, row, fq); float ssq = 0.f;
#pragma unroll
            for (int bj = 0; bj < 2; ++bj) { const size_t off = (size_t)row * DM + col0 + bj * 128;
#pragma unroll
                for (int n = 0; n < 2; ++n) { const v2u pw = *(const v2u*)(PLEF + (size_t)row * (2 * DM) + u.pn * 512 + (col0 - u.pn * 256) + bj * 128 + 4 * n); f4 o = acc[ai][bj][m][n];
                    o[0] = sigm(o[0] * rs) * bf_lo(pw.x); o[1] = sigm(o[1] * rs) * bf_hi(pw.x); o[2] = sigm(o[2] * rs) * bf_lo(pw.y); o[3] = sigm(o[3] * rs) * bf_hi(pw.y);
                    const v2u xw = *(const v2u*)(XB + off + 4 * n);
                    o[0] += bf_lo(xw.x); o[1] += bf_hi(xw.x); o[2] += bf_lo(xw.y); o[3] += bf_hi(xw.y);
                    ssq += (o[0] * o[0] + o[1] * o[1]) + (o[2] * o[2] + o[3] * o[3]); acc[ai][bj][m][n] = o; } }
            ssq += __shfl_xor(ssq, 16); ssq += __shfl_xor(ssq, 32);
            if (fq == 0) __hip_atomic_store((unsigned*)(SSF + ((size_t)u.pn * MTOT + row) * 4 + wc), __float_as_uint(ssq), __ATOMIC_RELAXED, __HIP_MEMORY_SCOPE_AGENT); }
        { const float rs = row_rstd(SS, rowx, fq); float ssq = 0.f; const size_t off = (size_t)rowx * DM + colx;
#pragma unroll
          for (int n = 0; n < 2; ++n) { const v2u pw = *(const v2u*)(PLEF + (size_t)rowx * (2 * DM) + u.pn * 512 + (colx - u.pn * 256) + 4 * n); f4 o = ex[n];
              o[0] = sigm(o[0] * rs) * bf_lo(pw.x); o[1] = sigm(o[1] * rs) * bf_hi(pw.x); o[2] = sigm(o[2] * rs) * bf_lo(pw.y); o[3] = sigm(o[3] * rs) * bf_hi(pw.y);
              const v2u xw = *(const v2u*)(XB + off + 4 * n);
              o[0] += bf_lo(xw.x); o[1] += bf_hi(xw.x); o[2] += bf_lo(xw.y); o[3] += bf_hi(xw.y);
              ssq += (o[0] * o[0] + o[1] * o[1]) + (o[2] * o[2] + o[3] * o[3]); ex[n] = o; }
          ssq += __shfl_xor(ssq, 16); ssq += __shfl_xor(ssq, 32);
          if (fq == 0) __hip_atomic_store((unsigned*)(SSFX + ((size_t)u.pn * NSAMPLE + (rowx - NPROMPT)) * 8 + wr * 4 + wc), __float_as_uint(ssq), __ATOMIC_RELAXED, __HIP_MEMORY_SCOPE_AGENT); }
        asm volatile("s_waitcnt vmcnt(0)" ::: "memory");
        unsigned* c = cnt + 64 * u.pm;
        if (fr == 0 && fq == 0) __hip_atomic_fetch_add(c, 1u, __ATOMIC_RELAXED, __HIP_MEMORY_SCOPE_AGENT);
        if (wr == 0 && wc == 0) { unsigned sp = 0;
            while ((unsigned)__builtin_amdgcn_readfirstlane((int)__hip_atomic_load(c, __ATOMIC_RELAXED, __HIP_MEMORY_SCOPE_AGENT)) < 64u && ++sp < (1u << 22)) __builtin_amdgcn_s_sleep(2);
            __builtin_amdgcn_fence(__ATOMIC_ACQUIRE, "agent");
            asm volatile("s_waitcnt vmcnt(0)" ::: "memory"); }
        asm volatile("" ::: "memory"); __builtin_amdgcn_s_barrier(); asm volatile("" ::: "memory");
#pragma unroll
        EPI_ROWS { const int row = row0 + ai * 128 + m * 16; const float rsf = row_rstd(SSF, row, fq);
#pragma unroll
            for (int bj = 0; bj < 2; ++bj) { const size_t off = (size_t)row * DM + col0 + bj * 128; const int c0 = col0 + bj * 128;
#pragma unroll
                for (int n = 0; n < 2; ++n) *(f4*)(XR + off + 4 * n) = acc[ai][bj][m][n] * rsf * *(const f4*)(lnf + c0 + 4 * n); } }
        { float sx = 0.f;
#pragma unroll
          for (int p = 0; p < 2; ++p) { const float* sp = SSFX + ((size_t)(2 * fq + p) * NSAMPLE + (rowx - NPROMPT)) * 8; const f4 a = *(const f4*)sp, b = *(const f4*)(sp + 4);
              sx += ((a[0] + a[1]) + (a[2] + a[3])) + ((b[0] + b[1]) + (b[2] + b[3])); }
          sx += __shfl_xor(sx, 16); sx += __shfl_xor(sx, 32);
          const float rsf = __builtin_amdgcn_rsqf(sx * (1.f / DM) + EPS);
#pragma unroll
          for (int n = 0; n < 2; ++n) *(f4*)(XR + (size_t)rowx * DM + colx + 4 * n) = ex[n] * rsf * *(const f4*)(lnf + colx + 4 * n); }
        return true;
    }
};
#undef EPI_ROWS
}

namespace scan {
typedef short v4i16_t __attribute__((ext_vector_type(4)));
__device__ __forceinline__ s16x4 vtr(const LAS unsigned char* p) { return __builtin_bit_cast(s16x4, __builtin_amdgcn_ds_read_tr16_b64_v4i16((LAS v4i16_t*)p)); }
__device__ __forceinline__ bf16x8 cat8(s16x4 lo, s16x4 hi) { return (bf16x8){lo[0], lo[1], lo[2], lo[3], hi[0], hi[1], hi[2], hi[3]}; }
template <int CTRL> __device__ __forceinline__ float dpp_mov(float v) { return __builtin_bit_cast(float, __builtin_amdgcn_update_dpp(0, __builtin_bit_cast(int, v), CTRL, 0xF, 0xF, true)); }
__device__ __forceinline__ float row16_sum(float v) { v += dpp_mov<0xB1>(v); v += dpp_mov<0x4E>(v); v += dpp_mov<0x141>(v); v += dpp_mov<0x140>(v); return v; }
typedef float f32x2_t __attribute__((ext_vector_type(2))); typedef __bf16 bf16x2_t __attribute__((ext_vector_type(2)));
__device__ __forceinline__ unsigned cvtpk(float lo, float hi) { f32x2_t v = {lo, hi}; bf16x2_t b = __builtin_convertvector(v, bf16x2_t); return __builtin_bit_cast(unsigned, b); }
__device__ __forceinline__ float logsig(float x) { return fminf(x, 0.f) - __logf(1.f + __expf(-fabsf(x))); }
struct Tensors { const bf16* Z; bf16* Zw; unsigned char* AD; float* LFS; const float* LOGF; const float* GLR; const float* wgk; const float* bgk; const float* hg_gain; const float* gla_gain; bf16* BR;
                 const float* st_h; const float* st_g; float* out; };
constexpr int AD_BYTES = 3072;
__device__ __forceinline__ void glds16(const void* gsrc, unsigned lds_dst) { unsigned keep;
    asm volatile("s_mov_b32 %0, m0\n\ts_mov_b32 m0, %2\n\ts_nop 0\n\tglobal_load_lds_dwordx4 %1, off\n\ts_mov_b32 m0, %0" : "=&s"(keep) : "v"(gsrc), "s"(lds_dst) : "memory"); }
__device__ __forceinline__ int fsw(int row) { return (2 * (row & 7)) ^ ((row >> 3) & 1); }
struct PreIn { f32x4 g0[2], g1[2]; float wv[8], bgv, lfr[8]; unsigned short qh[8], kh[8]; };
template <int KIND>
__device__ __forceinline__ void prepass_fetch(const Tensors& T, int it, int l15, int g, int kc, PreIn& I) {
    constexpr int NH = KIND ? GLH : HGH;
    const int sq = it >> 6, n = it & 63, b = sq / NH, h = sq % NH;
    const int qcol = KIND ? ZC_GQ + h * 128 : ZC_HQ + h * 128, kcol = KIND ? ZC_GK + h * 128 : ZC_HK + h * 128;
    const size_t r0 = (size_t)(b * SEQ + n * 32);
    if (KIND) { const float* wp = T.wgk + (size_t)(8 * (g & 1)) * 512 + h * 128 + kc;
#pragma unroll
        for (int e = 0; e < 8; ++e) I.wv[e] = wp[512 * e];
        I.bgv = T.bgk[h * 128 + kc]; }
#pragma unroll
    for (int tt = 0; tt < 2; ++tt) {
        if (KIND) { const float* gp = T.GLR + (r0 + 16 * tt + l15) * 16 + 8 * (g & 1); I.g0[tt] = *(const f32x4*)gp; I.g1[tt] = *(const f32x4*)(gp + 4); }
#pragma unroll
        for (int r = 0; r < 4; ++r) { const size_t row = r0 + 16 * tt + 4 * g + r;
            if (!KIND) I.lfr[4 * tt + r] = T.LOGF[row * 1024 + h * 128 + kc];
            I.qh[4 * tt + r] = T.Zw[row * LDZ + qcol + kc]; I.kh[4 * tt + r] = T.Zw[row * LDZ + kcol + kc]; } }
}
template <int KIND>
__device__ __forceinline__ void prepass_items(LAS unsigned char* lds, const Tensors& T, int bx, int G, int tid) {
    constexpr int RP = 288, TILE = 32 * RP, O_QE = 0, O_KE = TILE, NSEQ = KIND ? 16 : 32, SEQ0 = KIND ? 0 : 16, NH = KIND ? GLH : HGH;
    asm volatile("" : "+v"(tid));
    const int lane = tid & 63, wave = __builtin_amdgcn_readfirstlane(tid >> 6), l15 = lane & 15, g = lane >> 4, q4 = l15 >> 2, kc = 16 * wave + l15;
    const int wbase = 4 * g * RP + ((((kc >> 3) ^ (2 * g))) << 4) + (kc & 7) * 2;
    constexpr int NIT = NSEQ * (SEQ / 32);
    PreIn cur{}, nxt{};
    if (bx < NIT) prepass_fetch<KIND>(T, bx, l15, g, kc, cur);
    nxt = cur;
    for (int it = bx; it < NIT; it += G) {
        if (it + G < NIT) prepass_fetch<KIND>(T, it + G, l15, g, kc, nxt);
        const int sq = it >> 6, n = it & 63, b = sq / NH, h = sq % NH;
        const int qcol = KIND ? ZC_GQ + h * 128 : ZC_HQ + h * 128, kcol = KIND ? ZC_GK + h * 128 : ZC_HK + h * 128;
        const size_t r0 = (size_t)(b * SEQ + n * 32);
        unsigned char* ad = T.AD + ((size_t)(SEQ0 + sq) * (SEQ / 32) + n) * AD_BYTES;
        float lf[8]; unsigned short qh[8], kh[8];
#pragma unroll
        for (int tt = 0; tt < 2; ++tt) {
            if (KIND) { const f32x4 g0 = cur.g0[tt], g1 = cur.g1[tt];
                float x[8] = {g0[0], g0[1], g0[2], g0[3], g1[0], g1[1], g1[2], g1[3]};
#pragma unroll
                for (int e = 0; e < 8; ++e) { const float hi = __uint_as_float(f2bf(x[e]) << 16); x[e] = g >= 2 ? x[e] - hi : hi; }
                v4u a; a.x = cvtpk(x[0], x[1]); a.y = cvtpk(x[2], x[3]); a.z = cvtpk(x[4], x[5]); a.w = cvtpk(x[6], x[7]);
                v4u w; w.x = cvtpk(cur.wv[0], cur.wv[1]); w.y = cvtpk(cur.wv[2], cur.wv[3]); w.z = cvtpk(cur.wv[4], cur.wv[5]); w.w = cvtpk(cur.wv[6], cur.wv[7]);
                const float bgv = cur.bgv;
                const f32x4 d = __builtin_amdgcn_mfma_f32_16x16x32_bf16(__builtin_bit_cast(bf16x8, a), __builtin_bit_cast(bf16x8, w), (f32x4){bgv, bgv, bgv, bgv}, 0, 0, 0);
#pragma unroll
                for (int r = 0; r < 4; ++r) lf[4 * tt + r] = logsig(d[r]) * (1.4426950408889634f / 16.f); }
#pragma unroll
            for (int r = 0; r < 4; ++r) {
                if (!KIND) lf[4 * tt + r] = cur.lfr[4 * tt + r] * 1.4426950408889634f;
                qh[4 * tt + r] = cur.qh[4 * tt + r]; kh[4 * tt + r] = cur.kh[4 * tt + r]; } }
        lf[1] += lf[0]; lf[2] += lf[1]; lf[3] += lf[2]; lf[5] += lf[4]; lf[6] += lf[5]; lf[7] += lf[6];
        float s0[4], s1[4];
#pragma unroll
        for (int j = 0; j < 4; ++j) { s0[j] = __shfl(lf[3], l15 + 16 * j); s1[j] = __shfl(lf[7], l15 + 16 * j); }
        const float h0 = (s0[0] + s0[1]) + (s0[2] + s0[3]), last = h0 + ((s1[0] + s1[1]) + (s1[2] + s1[3]));
        const float pre = g == 0 ? 0.f : (g == 1 ? s0[0] : (g == 2 ? s0[0] + s0[1] : s0[0] + s0[1] + s0[2]));
        const float pre1 = h0 + (g == 0 ? 0.f : (g == 1 ? s1[0] : (g == 2 ? s1[0] + s1[1] : s1[0] + s1[1] + s1[2])));
        const float ref = h0 + __shfl(lf[4], l15);
        const float eref = __builtin_amdgcn_exp2f(ref), elr = __builtin_amdgcn_exp2f(last - ref);
#pragma unroll
        for (int e = 0; e < 8; ++e) { const float cum = lf[e] + (e < 4 ? pre : pre1), E = __builtin_amdgcn_exp2f(cum - ref), Ei = __builtin_amdgcn_exp2f(ref - cum);
            const float q = bf2f(qh[e]) * E, k = bf2f(kh[e]) * Ei; const int o = wbase + ((e >> 2) * 16 + (e & 3)) * RP;
            const unsigned a = cvtpk(q, q * eref), c = cvtpk(k, k * elr);
            *(LAS bf16*)(lds + O_QE + o) = (bf16)a; *(LAS bf16*)(lds + O_KE + o) = (bf16)c;
            const size_t row = r0 + (e >> 2) * 16 + 4 * g + (e & 3);
            T.Zw[row * LDZ + qcol + kc] = (bf16)(a >> 16); T.Zw[row * LDZ + kcol + kc] = (bf16)(c >> 16); }
        if (g == 0) *(float*)(ad + 2048 + kc * 4) = __builtin_amdgcn_exp2f(last);
        __syncthreads();
        if (wave < 3) { const int st = wave == 2 ? 1 : 0, tt = wave == 0 ? 0 : 1; f32x4 d = (f32x4){0.f, 0.f, 0.f, 0.f};
#pragma unroll
            for (int ks = 0; ks < 4; ++ks) { const int co = l15 * RP + ((((4 * ks + g) ^ (2 * q4))) << 4);
                d = __builtin_amdgcn_mfma_f32_16x16x32_bf16(*(const LAS bf16x8*)(lds + O_KE + 16 * st * RP + co), *(const LAS bf16x8*)(lds + O_QE + 16 * tt * RP + co), d, 0, 0, 0); }
            if (st == tt) {
#pragma unroll
                for (int r = 0; r < 4; ++r) d[r] = l15 >= 4 * g + r ? d[r] : 0.f; }
            *(v2u*)(ad + ((tt * 4 + g) * 16 + l15) * 16 + st * 8) = (v2u){cvtpk(d[0], d[1]), cvtpk(d[2], d[3])};
        } else if (wave == 3) *(v2u*)(ad + (g * 16 + l15) * 16 + 8) = (v2u){0u, 0u};
        __syncthreads();
        cur = nxt;
    }
}

template <int NV>
__device__ __forceinline__ void prompt_scan(LAS unsigned char* lds, const Tensors& T, int b, int h, int tid) {
    constexpr int KIND = NV - 1, V = 128 * NV, NST = 3, NCH = SEQ / 32; constexpr bool GLDS = NV == 1;
    constexpr int O_QIN = 0, O_KOUT = 8192, O_V = 16384, O_G = 16384 + 8192 * NV, O_AD = O_G + (GLDS ? 8192 * NV : 0), STG = O_AD + AD_BYTES, O_RED = NST * STG, O_DUMMY = O_RED + 2048;
    constexpr int NPG = GLDS ? 8 * NV : 0, NP = 19 + 8 * NV + NPG, PPW = (NP + 7) / 8;
    static_assert(O_DUMMY + 1024 <= RING_BYTES, "scan LDS");
    asm volatile("" : "+v"(tid));
    const int lane = tid & 63, wave = __builtin_amdgcn_readfirstlane(tid >> 6), l15 = lane & 15, g = lane >> 4;
    const int qcol = KIND ? ZC_GQ + h * 128 : ZC_HQ + h * 128, kcol = KIND ? ZC_GK + h * 128 : ZC_HK + h * 128;
    const int vcol = KIND ? ZC_GV + h * 256 : ZC_HV + h * 128, gcol = KIND ? ZC_GG + h * 256 : ZC_HG + h * 128, ocol = KIND ? 1024 + h * 256 : h * 128;
    const float* gain = KIND ? T.gla_gain : T.hg_gain;
    const int vw = wave * 16 * NV;
    const unsigned char* adq = T.AD + ((size_t)((KIND ? 0 : 16) + b * (KIND ? GLH : HGH) + h) * NCH) * AD_BYTES;
    f32x4 S[NV][8];
#pragma unroll
    for (int nv = 0; nv < NV; ++nv)
#pragma unroll
        for (int kt = 0; kt < 8; ++kt) S[nv][kt] = (f32x4){0.f, 0.f, 0.f, 0.f};
    float gn[NV];
#pragma unroll
    for (int nv = 0; nv < NV; ++nv) gn[nv] = gain[vw + 16 * nv + l15];
    const unsigned lds0 = (unsigned)(uintptr_t)lds;
    const unsigned char* psrc[PPW]; int pdst[PPW]; unsigned pstr[PPW];
#pragma unroll
    for (int j_ = 0; j_ < PPW; ++j_) { const int i_ = wave + 8 * j_; const size_t r0_ = (size_t)(b * SEQ);
        if (i_ < 16) { const int p_ = i_ & 7, row_ = 4 * p_ + (lane >> 4), c_ = lane & 15;
            psrc[j_] = (const unsigned char*)(T.Z + (r0_ + row_) * LDZ + (i_ < 8 ? qcol : kcol) + ((c_ ^ fsw(row_)) << 3)); pdst[j_] = (i_ < 8 ? O_QIN : O_KOUT) + p_ * 1024; pstr[j_] = 32u * LDZ * 2u; }
        else if (i_ < 16 + 8 * NV + NPG) { const int gsel_ = i_ >= 16 + 8 * NV, p_ = i_ - 16 - (gsel_ ? 8 * NV : 0), row_ = NV == 1 ? 4 * p_ + (lane >> 4) : 2 * p_ + (lane >> 5), c_ = NV == 1 ? (lane & 15) : (lane & 31);
            psrc[j_] = (const unsigned char*)(T.Z + (r0_ + row_) * LDZ + (gsel_ ? gcol : vcol) + ((gsel_ ? c_ : (c_ ^ fsw(row_))) << 3)); pdst[j_] = (gsel_ ? O_G : O_V) + p_ * 1024; pstr[j_] = 32u * LDZ * 2u; }
        else if (i_ < NP) { const int p_ = i_ - 16 - 8 * NV - NPG; psrc[j_] = adq + p_ * 1024 + lane * 16; pdst[j_] = O_AD + p_ * 1024; pstr[j_] = AD_BYTES; }
        else { psrc[j_] = adq + 2048 + lane * 16; pdst[j_] = -1; pstr[j_] = AD_BYTES; } }
#define SCAN_DMA(m, st) do { const int m_ = (m); const bool live_ = m_ < NCH; const unsigned mm_ = live_ ? (unsigned)m_ : (unsigned)(NCH - 1); \
        _Pragma("unroll") for (int j_ = 0; j_ < PPW; ++j_) { const int dst_ = (live_ && pdst[j_] >= 0) ? (st) * STG + pdst[j_] : O_DUMMY; \
            glds16(psrc[j_] + (size_t)mm_ * pstr[j_], (unsigned)__builtin_amdgcn_readfirstlane((int)(lds0 + dst_))); } } while (0)
    SCAN_DMA(0, 0); SCAN_DMA(1, 1); asm volatile("s_waitcnt vmcnt(%0)" :: "n"(PPW) : "memory");
    __builtin_amdgcn_s_barrier(); asm volatile("" ::: "memory");
    int st = 0;
    for (int n = 0; n < NCH; ++n) {
        const size_t row0 = (size_t)(b * SEQ + n * 32);
        int l15_ = lane & 15; asm volatile("" : "+v"(l15_));
        const int q4 = l15_ >> 2, p4 = l15_ & 3;
        unsigned gtr[2][NV][4];
        if (!GLDS) {
#pragma unroll
            for (int tt = 0; tt < 2; ++tt)
#pragma unroll
                for (int nv = 0; nv < NV; ++nv)
#pragma unroll
                    for (int r = 0; r < 4; ++r) { const bf16* gp_ = T.Z + (row0 + 16 * tt + 4 * g + r) * LDZ + gcol + vw + 16 * nv + l15_;
                        asm volatile("global_load_ushort %0, %1, off" : "=v"(gtr[tt][nv][r]) : "v"(gp_) : "memory"); } }
        { const int stn = st + NST - 1 >= NST ? st - 1 : st + NST - 1; SCAN_DMA(n + NST - 1, stn); }
        const LAS unsigned char* sb = lds + st * STG;
        bf16x8 Bv[NV];
#pragma unroll
        for (int nv = 0; nv < NV; ++nv) { const int row = 4 * g + q4, ch = ((vw + 16 * nv) >> 3) + (p4 >> 1);
            const LAS unsigned char* vp = sb + O_V + row * (2 * V) + ((ch ^ fsw(row)) << 4) + (p4 & 1) * 8;
            Bv[nv] = cat8(vtr(vp), vtr(vp + 16 * (2 * V))); }
        f32x4 o[2][NV];
#pragma unroll
        for (int tt = 0; tt < 2; ++tt) { const bf16x8 A = *(const LAS bf16x8*)(sb + O_AD + ((tt * 4 + g) * 16 + l15_) * 16);
#pragma unroll
            for (int nv = 0; nv < NV; ++nv) o[tt][nv] = __builtin_amdgcn_mfma_f32_16x16x32_bf16(A, Bv[nv], (f32x4){0.f, 0.f, 0.f, 0.f}, 0, 0, 0); }
        bf16x8 Aq[2][4];
#pragma unroll
        for (int tt = 0; tt < 2; ++tt) { const int row = 16 * tt + l15_, f = fsw(row); const LAS unsigned char* qp = sb + O_QIN + row * 256 + (g & 1) * 8;
#pragma unroll
            for (int ks = 0; ks < 4; ++ks) Aq[tt][ks] = cat8(*(const LAS s16x4*)(qp + (((4 * ks + (g >> 1)) ^ f) << 4)), *(const LAS s16x4*)(qp + (((4 * ks + 2 + (g >> 1)) ^ f) << 4))); }
        bf16x8 Ak[8]; f32x4 d4[8];
        { const int row = 4 * g + q4; const LAS unsigned char* kb = sb + O_KOUT + row * 256 + (p4 & 1) * 8; const int fk = fsw(row);
#pragma unroll
          for (int kt = 0; kt < 8; ++kt) { const LAS unsigned char* kp = kb + (((2 * kt + (p4 >> 1)) ^ fk) << 4); Ak[kt] = cat8(vtr(kp), vtr(kp + 16 * 256)); d4[kt] = *(const LAS f32x4*)(sb + O_AD + 2048 + (16 * kt + 4 * g) * 4); } }
#pragma unroll
        for (int ks = 0; ks < 4; ++ks) { bf16x8 Bs[NV];
#pragma unroll
            for (int nv = 0; nv < NV; ++nv) { const f32x4 s0 = S[nv][2 * ks], s1 = S[nv][2 * ks + 1]; v4u w; w.x = cvtpk(s0[0], s0[1]); w.y = cvtpk(s0[2], s0[3]); w.z = cvtpk(s1[0], s1[1]); w.w = cvtpk(s1[2], s1[3]); Bs[nv] = __builtin_bit_cast(bf16x8, w); }
#pragma unroll
            for (int tt = 0; tt < 2; ++tt)
#pragma unroll
                for (int nv = 0; nv < NV; ++nv) o[tt][nv] = __builtin_amdgcn_mfma_f32_16x16x32_bf16(Aq[tt][ks], Bs[nv], o[tt][nv], 0, 0, 0); }
#pragma unroll
        for (int kt = 0; kt < 8; ++kt)
#pragma unroll
            for (int nv = 0; nv < NV; ++nv) S[nv][kt] = __builtin_amdgcn_mfma_f32_16x16x32_bf16(Ak[kt], Bv[nv], S[nv][kt] * d4[kt], 0, 0, 0);
        if (GLDS) {
#pragma unroll
        for (int tt = 0; tt < 2; ++tt)
#pragma unroll
            for (int nv = 0; nv < NV; ++nv)
#pragma unroll
                for (int r = 0; r < 4; ++r) gtr[tt][nv][r] = *(const LAS bf16*)(sb + O_G + ((16 * tt + 4 * g + r) * V + vw + 16 * nv + l15_) * 2); }
        LAS float* red = (LAS float*)(lds + O_RED + (n & 1) * 1024);
#pragma unroll
        for (int tt = 0; tt < 2; ++tt)
#pragma unroll
            for (int r = 0; r < 4; ++r) { float p = 0.f;
#pragma unroll
                for (int nv = 0; nv < NV; ++nv) p += o[tt][nv][r] * o[tt][nv][r];
                p = row16_sum(p);
                if (l15_ == 0) red[wave * 32 + 16 * tt + 4 * g + r] = p; }
        if (GLDS) { if (n == 0) asm volatile("s_waitcnt vmcnt(%0) lgkmcnt(0)" :: "n"(PPW) : "memory"); else asm volatile("s_waitcnt vmcnt(%0) lgkmcnt(0)" :: "n"(PPW + 8 * NV) : "memory"); }
        else { asm volatile("s_waitcnt vmcnt(%0) lgkmcnt(0)" :: "n"(PPW) : "memory");
#pragma unroll
            for (int tt = 0; tt < 2; ++tt)
#pragma unroll
                for (int nv = 0; nv < NV; ++nv) asm volatile("" : "+v"(gtr[tt][nv][0]), "+v"(gtr[tt][nv][1]), "+v"(gtr[tt][nv][2]), "+v"(gtr[tt][nv][3])); }
        __builtin_amdgcn_s_barrier(); asm volatile("" ::: "memory");
#pragma unroll
        for (int tt = 0; tt < 2; ++tt) { f32x4 ra = *(const LAS f32x4*)(red + (l15_ & 7) * 32 + 16 * tt + 4 * g);
#pragma unroll
            for (int r = 0; r < 4; ++r) { float x = ra[r]; x += dpp_mov<0xB1>(x); x += dpp_mov<0x4E>(x); x += dpp_mov<0x141>(x); ra[r] = x; }
#pragma unroll
            for (int r = 0; r < 4; ++r) { const int t = 16 * tt + 4 * g + r; const float rs = __builtin_amdgcn_rsqf(ra[r] * (1.f / V) + EPS);
#pragma unroll
                for (int nv = 0; nv < NV; ++nv) { const int vc = vw + 16 * nv + l15_;
                    const float y = o[tt][nv][r] * rs * gn[nv] * __uint_as_float(gtr[tt][nv][r] << 16); T.BR[(row0 + t) * DM + ocol + vc] = (bf16)cvtpk(y, y); } } }
        st = st + 1 == NST ? 0 : st + 1;
    }
#undef SCAN_DMA
    asm volatile("s_waitcnt vmcnt(0)" ::: "memory");
    float* so = T.out + (KIND ? OUT_GP + (size_t)(b * GLH + h) * 128 * V : OUT_HP + (size_t)(b * HGH + h) * 128 * V);
#pragma unroll
    for (int nv = 0; nv < NV; ++nv)
#pragma unroll
        for (int kt = 0; kt < 8; ++kt)
#pragma unroll
            for (int r = 0; r < 4; ++r) so[(size_t)(16 * kt + 4 * g + r) * V + vw + 16 * nv + l15] = S[nv][kt][r];
    __syncthreads();
}

constexpr int SS_QE = 0, SS_KE = 2048, SS_QIN = 4096, SS_KOUT = 6144, SS_DEC = 8192, SS_ATT = 8704, SS_WS = 8768  , SS_V = 9216  , SS_RED = 13312  ;
__device__ __forceinline__ void lds_barrier() { asm volatile("s_waitcnt lgkmcnt(0)" ::: "memory"); __builtin_amdgcn_s_barrier(); asm volatile("" ::: "memory"); }
template <int NV>
__device__ __forceinline__ void ss_load_small(const Tensors& T, int b, int h, int tid, unsigned short (&qh)[4], unsigned short (&kh)[4], float (&lf)[4], f32x4 (&gl)[4][4], float (&wk)[16], float& bgv,
                                              unsigned short (&vh)[NV], unsigned short (&gh)[NV], float (&gnv)[NV]) {
    constexpr int KIND = NV - 1, V = 128 * NV;
    const int qcol = KIND ? ZC_GQ + h * 128 : ZC_HQ + h * 128, kcol = KIND ? ZC_GK + h * 128 : ZC_HK + h * 128, vcol = KIND ? ZC_GV + h * 256 : ZC_HV + h * 128, gcol = KIND ? ZC_GG + h * 256 : ZC_HG + h * 128;
    const float* gain = KIND ? T.gla_gain : T.hg_gain; const int row0 = NPROMPT + b * DECS, k = tid & 127;
#pragma unroll
    for (int t = 0; t < 4; ++t) { const size_t row = (size_t)(row0 + t); qh[t] = T.Z[row * LDZ + qcol + k]; kh[t] = T.Z[row * LDZ + kcol + k];
        if (!KIND) lf[t] = T.LOGF[row * 1024 + h * 128 + k];
        else lf[t] = T.LFS[(size_t)(row - NPROMPT) * 512 + h * 128 + k]; }
    (void)gl; (void)wk; (void)bgv;
#pragma unroll
    for (int j = 0; j < NV; ++j) { const int i = tid + 512 * j, t = i / V, v = i % V; vh[j] = T.Z[(size_t)(row0 + t) * LDZ + vcol + v]; gh[j] = T.Z[(size_t)(row0 + t) * LDZ + gcol + v]; gnv[j] = gain[v]; }
}
template <int NV>
__device__ __forceinline__ int sample_scan(LAS unsigned char* lds, const Tensors& T, int b, int h, f32x4 (&sreg)[(128 * NV / 4) * 128 / 512], unsigned short (&qh)[4], unsigned short (&kh)[4], float (&lf)[4],
                                           f32x4 (&gl)[4][4], float (&wk)[16], float& bgv, unsigned short (&vh)[NV], unsigned short (&gh)[NV], float (&gnv)[NV], volatile LAS unsigned* nxt_word, int nitems, int tid) {
    constexpr int KIND = NV - 1, V = 128 * NV, V4 = V / 4, KR = 512 / V4, NR = 128 / KR, H = KIND ? GLH : HGH;
    asm volatile("" : "+v"(tid));
    const int lane = tid & 63, wave = __builtin_amdgcn_readfirstlane(tid >> 6);
    const int ocol = KIND ? 1024 + h * 256 : h * 128;
    const int row0 = NPROMPT + b * DECS;
    LAS float* qe = (LAS float*)(lds + SS_QE); LAS float* ke = (LAS float*)(lds + SS_KE); LAS float* qin = (LAS float*)(lds + SS_QIN); LAS float* kout = (LAS float*)(lds + SS_KOUT);
    LAS float* dec = (LAS float*)(lds + SS_DEC); LAS float* att = (LAS float*)(lds + SS_ATT); LAS float* wsum = (LAS float*)(lds + SS_WS); LAS float* vs = (LAS float*)(lds + SS_V); LAS float* red = (LAS float*)(lds + SS_RED);
    const int k = tid & 127;
    const int vq = tid % V4, kr = tid / V4;
    if (tid < 128) { float qv[4], kv[4];
#pragma unroll
        for (int t = 0; t < 4; ++t) { qv[t] = bf2f(qh[t]); kv[t] = bf2f(kh[t]); }
        lf[1] += lf[0]; lf[2] += lf[1]; lf[3] += lf[2];
#pragma unroll
        for (int t = 0; t < 4; ++t) { qe[t * 128 + k] = qv[t] * __expf(lf[t] - lf[2]); ke[t * 128 + k] = kv[t] * __expf(lf[2] - lf[t]); qin[t * 128 + k] = qv[t] * __expf(lf[t]); kout[t * 128 + k] = kv[t] * __expf(lf[3] - lf[t]); }
        dec[k] = __expf(lf[3]); }
#pragma unroll
    for (int j = 0; j < NV; ++j) vs[tid + 512 * j] = bf2f(vh[j]);
    lds_barrier();
    { const int pair = tid >> 5, t = pair >> 2, s = pair & 3, j = tid & 31; float a = 0.f;
#pragma unroll
      for (int i = 0; i < 4; ++i) a += qe[t * 128 + j + 32 * i] * ke[s * 128 + j + 32 * i];
      a += __shfl_xor(a, 16); a += __shfl_xor(a, 8); a += __shfl_xor(a, 4); a += __shfl_xor(a, 2); a += __shfl_xor(a, 1);
      if (j == 0) att[pair] = s <= t ? a : 0.f; }
    { float* sout = T.out + (KIND ? OUT_GS : OUT_HS) + (size_t)(b * H + h) * 128 * V;
      f32x4 vv[4], acc[4];
#pragma unroll
      for (int t = 0; t < 4; ++t) { vv[t] = *(const LAS f32x4*)(vs + t * V + 4 * vq); acc[t] = (f32x4){0.f, 0.f, 0.f, 0.f}; }
#pragma unroll
      for (int i = 0; i < NR; ++i) { const int k = kr + KR * i; const f32x4 s0 = sreg[i]; f32x4 sn = s0 * dec[k];
#pragma unroll
          for (int t = 0; t < 4; ++t) { acc[t] += s0 * qin[t * 128 + k]; sn += vv[t] * kout[t * 128 + k]; }
          *(f32x4*)(sout + (size_t)k * V + 4 * vq) = sn; }
#pragma unroll
      for (int t = 0; t < 4; ++t) *(LAS f32x4*)(red + (kr * 4 + t) * V + 4 * vq) = acc[t]; }
    const int nxt = (int)nxt_word[0];
    unsigned short gh2[NV]; float gnv2[NV];
#pragma unroll
    for (int j = 0; j < NV; ++j) { gh2[j] = gh[j]; gnv2[j] = gnv[j]; }
    if (nxt < nitems) { ss_load_small<NV>(T, nxt / H, nxt % H, tid, qh, kh, lf, gl, wk, bgv, vh, gh2, gnv2);
        const float* sn_ = (KIND ? T.st_g : T.st_h) + (size_t)nxt * 128 * V;
#pragma unroll
        for (int i = 0; i < NR; ++i) sreg[i] = *(const GAS f32x4*)(sn_ + (size_t)(kr + KR * i) * V + 4 * vq); }
    lds_barrier();
    float ov[NV];
#pragma unroll
    for (int j = 0; j < NV; ++j) { const int idx = tid + 512 * j, t = idx / V, v = idx % V; float o = 0.f;
#pragma unroll
        for (int kr = 0; kr < KR; ++kr) o += red[(kr * 4 + t) * V + v];
#pragma unroll
        for (int s = 0; s < 4; ++s) o += att[t * 4 + s] * vs[s * V + v];
        ov[j] = o; const float p = wave_sum(o * o); if (lane == 0) wsum[j * 8 + wave] = p; }
    lds_barrier();
#pragma unroll
    for (int j = 0; j < NV; ++j) { const int idx = tid + 512 * j, t = idx / V, v = idx % V; float tot = 0.f;
#pragma unroll
        for (int jj = 0; jj < NV; ++jj)
#pragma unroll
            for (int w = 0; w < 8; ++w) { const int tw = (w * 64 + 512 * jj) / V; tot += (tw == t) ? wsum[jj * 8 + w] : 0.f; }
        const float rs = __builtin_amdgcn_rsqf(tot * (1.f / V) + EPS); const size_t row = (size_t)(row0 + t);
        T.BR[row * DM + ocol + v] = (bf16)f2bf(ov[j] * rs * gnv[j] * bf2f(gh[j])); gh[j] = gh2[j]; gnv[j] = gnv2[j]; }
    lds_barrier();
    return nxt;
}
template <int NV>
__device__ __forceinline__ void sample_loop(LAS unsigned char* lds, const Tensors& T, volatile LAS unsigned* MISC, gu32* q, int tid) {
    constexpr int KIND = NV - 1, V = 128 * NV, V4 = V / 4, KR = 512 / V4, NR = 128 / KR, H = KIND ? GLH : HGH, NIT = DECB * H;
    if (tid == 0) MISC[16] = __hip_atomic_fetch_add(q, 1u, RLX_AGENT);
    __syncthreads();
    int cur = (int)MISC[16];
    __syncthreads();
    if (cur >= NIT) return;
    f32x4 sreg[NR]; unsigned short qh[4], kh[4], vh[NV], gh[NV]; float lf[4], wk[16], gnv[NV], bgv = 0.f; f32x4 gl[4][4];
    ss_load_small<NV>(T, cur / H, cur % H, tid, qh, kh, lf, gl, wk, bgv, vh, gh, gnv);
    { const int vq = tid % V4, kr = tid / V4; const float* sn_ = (KIND ? T.st_g : T.st_h) + (size_t)cur * 128 * V;
#pragma unroll
      for (int i = 0; i < NR; ++i) sreg[i] = *(const GAS f32x4*)(sn_ + (size_t)(kr + KR * i) * V + 4 * vq); }
    for (;;) {
        if (tid == 0) MISC[17] = __hip_atomic_fetch_add(q, 1u, RLX_AGENT);
        const int nxt = sample_scan<NV>(lds, T, cur / H, cur % H, sreg, qh, kh, lf, gl, wk, bgv, vh, gh, gnv, MISC + 17, NIT, tid);
        if (nxt >= NIT) break;
        cur = nxt;
    }
}
}

struct Args { const float* in[22]; float* out; unsigned char* ws; int ph_lo, ph_hi, li, pad; };
#ifndef MK_CUTS
#define MK_CUTS 0, 9
#endif
constexpr int N_PHASES = 8;
#ifndef SF_NUM
#define SF_NUM 9
#endif
constexpr int N_DEFER = 16 * (MTOT / 256);
enum { I_XP = 0, I_XS, I_STH, I_STG, I_PP, I_PS, I_HGLB, I_LN1, I_WIN, I_HGN, I_WGK, I_BGK, I_GLN, I_WBR, I_WOUT, I_LN2, I_WGU, I_WDN, I_LN3, I_WPLE, I_WPG, I_LNF };

__global__ void __launch_bounds__(NWAVES * 64, 2) mega_fwd(Args args) {
    extern __shared__ __attribute__((aligned(16))) unsigned char lds_raw[];
    LAS unsigned char* lds = (LAS unsigned char*)lds_raw;
    volatile LAS unsigned* MISC = (volatile LAS unsigned*)(lds + MISC_OFF);
    const int G = gridDim.x, bx = blockIdx.x;
#define FRESH_IDS int tid = threadIdx.x; asm volatile("" : "+v"(tid)); const int lane = tid & 63, wave = __builtin_amdgcn_readfirstlane(tid >> 6); (void)lane; (void)wave;
    unsigned char* ws = args.ws;
    gu32* ctl = (gu32*)(ws + WS_CTL);
    bf16* Win_t = (bf16*)(ws + WS_WIN); bf16* Wb_t = (bf16*)(ws + WS_WB); bf16* Wout_t = (bf16*)(ws + WS_WOUT); bf16* Wgu_t = (bf16*)(ws + WS_WGU);
    bf16* Wdn_t = (bf16*)(ws + WS_WDN); bf16* Wpg_t = (bf16*)(ws + WS_WPG); bf16* Wple_t = (bf16*)(ws + WS_WPLE);
    bf16* PB = (bf16*)(ws + WS_PB); float* RSTD1 = (float*)(ws + WS_RSTD1); float* GLR = (float*)(ws + WS_GLR);
    float* SS2 = (float*)(ws + WS_SS2); float* SS3 = (float*)(ws + WS_SS3); float* SSF = (float*)(ws + WS_SSF);
    bf16* BUFA = (bf16*)(ws + WS_BUFA); bf16* BUFB = (bf16*)(ws + WS_BUFB); float* LOGF = (float*)(ws + WS_LOGF);
    bf16* Z = (bf16*)(ws + WS_Z); bf16* ACT = (bf16*)(ws + WS_Z); bf16* PLEF = (bf16*)(args.out + OUT_Y);
    float* XR = args.out + OUT_Y;
    for (int u = threadIdx.x; u < (LDS_BYTES - LDSCTL_OFF) / 4; u += NWAVES * 64) ((LAS unsigned*)(lds + LDSCTL_OFF))[u] = 0u;
    __syncthreads();
    const int ph_lo = args.ph_lo, ph_hi = args.ph_hi; int nbar = 0;
#define IN(k) (ph_lo <= (k) && (k) < ph_hi)
    int my_xcc = (int)(xb_xcc_id() & 15u), xcc_fast = -1;
    if (threadIdx.x == 0) __hip_atomic_fetch_add(ctl + CW_XCC + 64 * my_xcc, 1u, RLX_AGENT);
#define XCC_DECIDE() do { volatile LAS int* xw_ = (volatile LAS int*)(lds + LDSCTL_OFF + 128); \
        if (threadIdx.x == 0) { int r_ = -1; if ((G % 8) == 0) { unsigned sp_ = 0; bool ok_ = false; \
                for (;;) { unsigned sum_ = 0; ok_ = true; for (int j_ = 0; j_ < 16; ++j_) { const unsigned c_ = __hip_atomic_load(ctl + CW_XCC + 64 * j_, RLX_AGENT); sum_ += c_; ok_ = ok_ && (c_ == (j_ < 8 ? (unsigned)(G / 8) : 0u)); } \
                    if (sum_ >= (unsigned)G || ++sp_ > (1u << 20)) break; __builtin_amdgcn_s_sleep(2); } \
                if (ok_) r_ = my_xcc; } \
            xw_[0] = r_; } \
        __syncthreads(); xcc_fast = __builtin_amdgcn_readfirstlane(xw_[0]); } while (0)
#define SEAM(k) do { if (IN(k) && IN((k) + 1)) { if (nbar == 0) XCC_DECIDE(); ++nbar; grid_barrier(ctl + CW_BAR + args.li * 4096, (unsigned)nbar, G, bx, xcc_fast); } } while (0)

    if (IN(0)) {
        FRESH_IDS
        const int gw = bx * NWAVES + wave, NGW = G * NWAVES; (void)gw; (void)NGW;
        {
            LAS unsigned* img = (LAS unsigned*)(lds + RING_OFF);
            int base = 0;
#define P0_MAT(Wp, ks, WTp, Kk, Nn, md) do { const P0Mat m_{Wp, ks, WTp, Kk, Nn, md, ((Kk) / 64) * (((Nn) + 255) / 256)}; \
                int t_ = bx - (base % G); if (t_ < 0) t_ += G;            \
                f32x4 va[8], vb[8]; \
                if (t_ < m_.tiles) p0_tile_load(m_, t_, va, tid); \
                for (; t_ < m_.tiles; t_ += G) { \
                    if (t_ + G < m_.tiles) p0_tile_load(m_, t_ + G, vb, tid); \
                    p0_tile_store(m_, t_, va, img, tid); \
                    _Pragma("unroll") for (int e = 0; e < 8; ++e) va[e] = vb[e]; } \
                base += m_.tiles; } while (0)
            P0_MAT(args.in[I_WIN], args.in[I_LN1], Win_t, DM, INCOLS, 1);
#undef P0_MAT
        }
        for (int i = bx * 512 + tid; i < (N1PAD - INCOLS) * DM / 8; i += G * 512) *(GAS v4u*)(Win_t + (size_t)INCOLS * DM + (size_t)i * 8) = (v4u){0u, 0u, 0u, 0u};
        for (int mb = bx; mb < MTOT / 32; mb += G) for (int m = mb * 32 + wave; m < mb * 32 + 32; m += NWAVES) {
            const float* xrow = m < NPROMPT ? args.in[I_XP] + (size_t)m * DM : args.in[I_XS] + (size_t)(m - NPROMPT) * DM;
            const GAS f32x4* xr = (const GAS f32x4*)xrow + lane; f32x4 v[8]; float s = 0.f;
#pragma unroll
            for (int j = 0; j < 8; ++j) { v[j] = xr[64 * j]; s += (v[j].x * v[j].x + v[j].y * v[j].y) + (v[j].z * v[j].z + v[j].w * v[j].w); }
            s = wave_sum(s);
            GAS v2u* o8 = (GAS v2u*)(BUFA + (size_t)m * DM) + lane;
#pragma unroll
            for (int j = 0; j < 8; ++j) o8[64 * j] = (v2u){pk2(v[j].x, v[j].y), pk2(v[j].z, v[j].w)};
            if (lane == 0) RSTD1[m] = __builtin_amdgcn_rsqf(s * (1.f / DM) + EPS);
            const float* prow = m < NPROMPT ? args.in[I_PP] + (size_t)m * PLE : args.in[I_PS] + (size_t)(m - NPROMPT) * PLE;
            const f32x4 pv = ((const GAS f32x4*)prow)[lane];
            ((GAS v2u*)(PB + (size_t)m * PLE))[lane] = (v2u){pk2(pv.x, pv.y), pk2(pv.z, pv.w)};
        }
    }
    SEAM(0);

    if (IN(1)) {
        pg8::Sched S{MTOT / 256, 29, (MTOT / 256) * 29, G, bx, 1, (const char*)BUFA, (const char*)Win_t, (size_t)256 * DM * 2, (size_t)256 * DM * 2, 0, 0, 28, 44};
        epi::Epi1 E{Z, LOGF, GLR, RSTD1, args.in[I_HGLB]};
        { const int r1 = (bx % 3) + 1;
          pg8::Sched Sa = S; Sa.icount = r1; pg8::gemm_phase(lds + RING_OFF, pg8::Gemm{DM, DM, DM / 64}, Sa, E);
          { FRESH_IDS
            LAS unsigned* img = (LAS unsigned*)(lds + RING_OFF);
            constexpr int T_GU = (DM / 64) * (2 * DFF / 256), T_DN = (DFF / 64) * (DM / 256), T_SQ = (DM / 64) * (DM / 256), T_BR = (1024 / 64) * (DM / 256), T_PL = (PLE / 64) * (DM / 256);
            constexpr int T_TOT = T_GU + T_DN + 2 * T_SQ + 2 * T_BR + T_PL;
#define P0_PICK(gid, m, lt) do { int r_ = (gid); \
                if (r_ < T_GU) { m = P0Mat{args.in[I_WGU], args.in[I_LN2], Wgu_t, DM, 2 * DFF, 2, T_GU}; lt = r_; } else { r_ -= T_GU; \
                if (r_ < T_DN) { m = P0Mat{args.in[I_WDN], nullptr, Wdn_t, DFF, DM, 0, T_DN}; lt = r_; } else { r_ -= T_DN; \
                if (r_ < T_SQ) { m = P0Mat{args.in[I_WOUT], nullptr, Wout_t, DM, DM, 0, T_SQ}; lt = r_; } else { r_ -= T_SQ; \
                if (r_ < T_SQ) { m = P0Mat{args.in[I_WPG], args.in[I_LN3], Wpg_t, DM, DM, 0, T_SQ}; lt = r_; } else { r_ -= T_SQ; \
                if (r_ < T_BR) { m = P0Mat{args.in[I_WBR], nullptr, Wb_t, 1024, DM, 0, T_BR}; lt = r_; } else { r_ -= T_BR; \
                if (r_ < T_BR) { m = P0Mat{args.in[I_WBR] + (size_t)1024 * DM, nullptr, Wb_t + (size_t)DM * 1024, 1024, DM, 0, T_BR}; lt = r_; } else { r_ -= T_BR; \
                m = P0Mat{args.in[I_WPLE], nullptr, Wple_t, PLE, DM, 0, T_PL}; lt = r_; } } } } } } } while (0)
            P0Mat ma{}, mb{}, mc{}; int la = 0, lb = 0, lc = 0; f32x4 va[8], vb[8], vc[8];
            if (bx < T_TOT) { P0_PICK(bx, ma, la); p0_tile_load(ma, la, va, tid); }
            if (bx + G < T_TOT) { P0_PICK(bx + G, mb, lb); p0_tile_load(mb, lb, vb, tid); }
            for (int gt = bx; gt < T_TOT; gt += G) {
                if (gt + 2 * G < T_TOT) { P0_PICK(gt + 2 * G, mc, lc); p0_tile_load(mc, lc, vc, tid); }
                p0_tile_store(ma, la, va, img, tid);
                ma = mb; la = lb; mb = mc; lb = lc;
#pragma unroll
                for (int e = 0; e < 8; ++e) { va[e] = vb[e]; vb[e] = vc[e]; } }
#undef P0_PICK
          }
          pg8::Sched Sb = S; Sb.i0 = r1; pg8::gemm_phase(lds + RING_OFF, pg8::Gemm{DM, DM, DM / 64}, Sb, E); }
        const int nfull = (MTOT / 256) * 29, rem = nfull % G, n_early = (G >= 96 && rem) ? G - rem : 0;
        if (n_early && bx >= rem) { pg8::SchedList SL{N_DEFER - n_early + (bx - rem), G, N_DEFER, MTOT / 256, 28, (const char*)BUFA, (const char*)Win_t, (size_t)256 * DM * 2, (size_t)256 * DM * 2};
            pg8::gemm_phase(lds + RING_OFF, pg8::Gemm{DM, DM, DM / 64}, SL, E); }
    }
    SEAM(1);

    if (IN(2)) {
        FRESH_IDS
        scan::Tensors T{Z, Z, ws + WS_AD, (float*)(ws + WS_AD + 10 * MiB), LOGF, GLR, args.in[I_WGK], args.in[I_BGK], args.in[I_HGN], args.in[I_GLN], BUFB, args.in[I_STH], args.in[I_STG], args.out};
        for (int i = bx * 512 + tid; i < NSAMPLE * 512; i += G * 512) { const int row = i >> 9, col = i & 511; float x = args.in[I_BGK][col];
            const float* gr = GLR + (size_t)(NPROMPT + row) * 16;
#pragma unroll
            for (int r = 0; r < 16; ++r) x += gr[r] * args.in[I_WGK][r * 512 + col];
            T.LFS[i] = scan::logsig(x) * (1.f / 16.f); }
        if (G >= 96) {
            gu32* cG = ctl + CW_PRE; gu32* cH = ctl + CW_PRE + 64;
            scan::prepass_items<1>(lds, T, bx, G, tid);
            const unsigned n_arr = xcc_fast >= 0 ? 8u : (unsigned)G;
            cnt_arrive_x(cG, ctl + CW_PSUB, xcc_fast, (unsigned)(G / 8));
            if (bx >= 16) scan::prepass_items<0>(lds, T, bx - 16, G - 16, tid);
            cnt_arrive_x(cH, ctl + CW_PSUB + 512, xcc_fast, (unsigned)(G / 8));
            if (bx < 16) { cnt_wait(cG, n_arr); scan::prompt_scan<2>(lds, T, bx >> 2, bx & 3, tid); }
            else if (bx < 48) { cnt_wait(cH, n_arr); scan::prompt_scan<1>(lds, T, (bx - 16) >> 3, (bx - 16) & 7, tid); }
            else { const int nfull = (MTOT / 256) * 29, rem = nfull % G, n_early = rem ? G - rem : 0, n_units = N_DEFER - n_early;
                const int idx = bx - 48, nb = (G - 48) / 16, blk = idx / 16, r16 = idx % 16, tail = (G - 48) - 16 * nb;
                const bool sf = blk < nb && r16 < SF_NUM;
                const int n_odd = nb * SF_NUM, n_even = (G - 48) - n_odd, hi = sf ? blk * SF_NUM + r16 : (blk < nb ? blk * (16 - SF_NUM) + (r16 - SF_NUM) : nb * (16 - SF_NUM) + r16);
                const int n_ev_units = 3 * n_even < n_units ? 3 * n_even : n_units; (void)tail;
                epi::Epi1 E{Z, LOGF, GLR, RSTD1, args.in[I_HGLB]};
                if (sf) {
                    cnt_wait(cH, n_arr);
                    scan::sample_loop<2>(lds, T, MISC, ctl + CW_Q, tid);
                    scan::sample_loop<1>(lds, T, MISC, ctl + CW_Q + 64, tid);
                    pg8::SchedList SL{n_ev_units + hi, n_odd, n_units, MTOT / 256, 28, (const char*)BUFA, (const char*)Win_t, (size_t)256 * DM * 2, (size_t)256 * DM * 2};
                    pg8::gemm_phase(lds + RING_OFF, pg8::Gemm{DM, DM, DM / 64}, SL, E);
                } else {
                    pg8::SchedList SL{hi, n_even, n_ev_units, MTOT / 256, 28, (const char*)BUFA, (const char*)Win_t, (size_t)256 * DM * 2, (size_t)256 * DM * 2};
                    pg8::gemm_phase(lds + RING_OFF, pg8::Gemm{DM, DM, DM / 64}, SL, E); } }
            if (bx >= 16) { const int j = bx >= 48 ? bx - 48 : (G - 48) + (bx - 16);
                pg8::SchedList SLP{j, G - 16, (NPROMPT / 256) * (DM / 256), NPROMPT / 256, 0, (const char*)PB, (const char*)Wple_t, (size_t)256 * PLE * 2, (size_t)256 * PLE * 2};
                epi::EpiPle E2{PLEF}; pg8::gemm_phase_t<true>(lds + RING_OFF, pg8::Gemm{PLE, PLE, PLE / 64}, SLP, E2); }
            cnt_wait(cH, n_arr);
        } else {
            scan::prepass_items<1>(lds, T, bx, G, tid);
            scan::prepass_items<0>(lds, T, bx, G, tid);
            ++nbar; grid_barrier(ctl + CW_BAR + args.li * 4096, (unsigned)nbar, G, bx, xcc_fast);
            { pg8::SchedList SL{bx, G, 16 * (MTOT / 256), MTOT / 256, 28, (const char*)BUFA, (const char*)Win_t, (size_t)256 * DM * 2, (size_t)256 * DM * 2};
              epi::Epi1 E{Z, LOGF, GLR, RSTD1, args.in[I_HGLB]};
              pg8::gemm_phase(lds + RING_OFF, pg8::Gemm{DM, DM, DM / 64}, SL, E); }
            for (int sq = bx; sq < 48; sq += G) {
                if (sq < 16) scan::prompt_scan<2>(lds, T, sq >> 2, sq & 3, tid);
                else scan::prompt_scan<1>(lds, T, (sq - 16) >> 3, (sq - 16) & 7, tid);
            }
        }
        scan::sample_loop<2>(lds, T, MISC, ctl + CW_Q, tid);
        scan::sample_loop<1>(lds, T, MISC, ctl + CW_Q + 64, tid);
    }
    SEAM(2);

    const bool panel_ok = (G == 256);
    int my_pm = 0; { pg8::Sched S0{NPROMPT / 256, DM / 256, (NPROMPT / 256) * (DM / 256), G, bx, 1, nullptr, nullptr, 0, 0, 0, 0}; pg8::Unit u0; if (S0.next(0, u0)) my_pm = u0.pm; }
    const bool ple_first = false, ple_in_p2 = (G >= 96) && IN(2);
#define PLE_GEMM() do { pg8::Sched S2{NPROMPT / 256, DM / 256, (NPROMPT / 256) * (DM / 256), G, bx, 1, (const char*)PB, (const char*)Wple_t, (size_t)256 * PLE * 2, (size_t)256 * PLE * 2, 0, 0}; \
        epi::EpiPle E2{PLEF}; pg8::gemm_phase_t<true>(lds + RING_OFF, pg8::Gemm{PLE, PLE, PLE / 64}, S2, E2); } while (0)
    if (IN(3)) {
        if (ple_first) PLE_GEMM();
        pg8::Sched S{NPROMPT / 256, DM / 256, (NPROMPT / 256) * (DM / 256), G, bx, 2, (const char*)BUFB, (const char*)Wb_t, (size_t)256 * DM * 2, (size_t)256 * 1024 * 2, (size_t)1024 * 2, (size_t)DM * 1024 * 2};
        epi::Epi2 E{Z, BUFA};
        pg8::gemm_phase_t<true>(lds + RING_OFF, pg8::Gemm{DM, 1024, 1024 / 64}, S, E);
    }
    if (panel_ok) { if (IN(3) && IN(4)) panel_barrier(ctl + CW_PB3 + 64 * my_pm, 8u, false);       } else SEAM(3);

    if (IN(4)) {
        pg8::Sched S{NPROMPT / 256, DM / 256, (NPROMPT / 256) * (DM / 256), G, bx, 1, (const char*)BUFA, (const char*)Wout_t, (size_t)256 * DM * 2, (size_t)256 * DM * 2, 0, 0};
        epi::EpiRes<false> E{args.in[I_XP], args.in[I_XS], nullptr, BUFB, SS2, (LAS float*)(lds + XS_OFF)};
        pg8::gemm_phase_t<true>(lds + RING_OFF, pg8::Gemm{DM, DM, DM / 64}, S, E);
        if (!ple_first && !ple_in_p2) PLE_GEMM();
    }
#undef PLE_GEMM
    SEAM(4);

    if (IN(5)) {
        pg8::Sched S{MTOT / 256, 2 * DFF / 256, (MTOT / 256) * (2 * DFF / 256), G, bx, 1, (const char*)BUFB, (const char*)Wgu_t, (size_t)256 * DM * 2, (size_t)256 * DM * 2, 0, 0};
        epi::Epi4 E{SS2, ACT};
        pg8::gemm_phase(lds + RING_OFF, pg8::Gemm{DM, DM, DM / 64}, S, E);
    }
    SEAM(5);

    if (IN(6)) {
        pg8::Sched S{NPROMPT / 256, DM / 256, (NPROMPT / 256) * (DM / 256), G, bx, 1, (const char*)ACT, (const char*)Wdn_t, (size_t)256 * DFF * 2, (size_t)256 * DFF * 2, 0, 0};
        epi::EpiRes<true> E{nullptr, nullptr, BUFB, BUFA, SS3, (LAS float*)(lds + XS_OFF)};
        pg8::gemm_phase_t<true>(lds + RING_OFF, pg8::Gemm{DFF, DFF, DFF / 64}, S, E);
    }
    if (panel_ok) { if (IN(6) && IN(7)) panel_barrier(ctl + CW_PB6 + 64 * my_pm, 8u, false);       } else SEAM(6);

    if (IN(7)) {
        pg8::Sched S{NPROMPT / 256, DM / 256, (NPROMPT / 256) * (DM / 256), G, bx, 1, (const char*)BUFA, (const char*)Wpg_t, (size_t)256 * DM * 2, (size_t)256 * DM * 2, 0, 0};
        epi::Epi6 E{SS3, PLEF, BUFA, XR, SSF, (float*)(ws + WS_SSFX), args.in[I_LNF], (unsigned*)(ctl + CW_PAN)};
        pg8::gemm_phase_t<true>(lds + RING_OFF, pg8::Gemm{DM, DM, DM / 64}, S, E);
    }
}

extern "C" void kernel_launch(void* const* d_in, const int* in_sizes, int n_in, void* d_out, int out_size, void* d_ws, size_t ws_size, hipStream_t stream) {
    static int grid = 0;
    if (grid == 0) {
        if (n_in != 22 || (size_t)out_size != OUT_END || ws_size < WS_END) { fprintf(stderr, "kernel_launch: unexpected shapes (n_in %d, out %d, ws %zu): nothing launched\n", n_in, out_size, ws_size); grid = -1; return; }
        int dev = 0, cus = 0;
        if (hipGetDevice(&dev) != hipSuccess || hipDeviceGetAttribute(&cus, hipDeviceAttributeMultiprocessorCount, dev) != hipSuccess) { grid = -1; return; }
        if (hipFuncSetAttribute((const void*)mega_fwd, hipFuncAttributeMaxDynamicSharedMemorySize, LDS_BYTES) != hipSuccess) { fprintf(stderr, "kernel_launch: hipFuncSetAttribute failed\n"); grid = -1; return; }
        int per_cu = 0;
        if (hipOccupancyMaxActiveBlocksPerMultiprocessor(&per_cu, (const void*)mega_fwd, NWAVES * 64, LDS_BYTES) != hipSuccess || per_cu < 1) { fprintf(stderr, "kernel_launch: occupancy query reports %d workgroups per CU\n", per_cu); }
        (void)hipGetLastError();
        if (per_cu < 1) { grid = -1; return; }
        grid = cus;
    }
    if (grid < 0) return;
    (void)hipMemsetAsync((char*)d_ws + WS_CTL, 0, CTL_ZERO_BYTES, stream);
    Args a{};
    for (int i = 0; i < 22; ++i) a.in[i] = (const float*)d_in[i];
    a.out = (float*)d_out; a.ws = (unsigned char*)d_ws;
    static const int cuts[] = { MK_CUTS };
    constexpr int NL = (int)(sizeof(cuts) / sizeof(int)) - 1;
    for (int li = 0; li < NL; ++li) { a.ph_lo = cuts[li]; a.ph_hi = cuts[li + 1]; a.li = li; hipLaunchKernelGGL(mega_fwd, dim3(grid), dim3(NWAVES * 64), LDS_BYTES, stream, a); }
}
```

```cpp
#include <hip/hip_runtime.h>
#include <cstdio>
#include <cstdint>

namespace pg8 {
#define PG8_LAS __attribute__((address_space(3)))
typedef unsigned short bf16_t;
typedef short bf16x8 __attribute__((ext_vector_type(8)));
typedef float f32x4 __attribute__((ext_vector_type(4)));
typedef unsigned u32x4 __attribute__((ext_vector_type(4)));
constexpr int BM = 256, BK = 64, HALF = 128, HTB = HALF * BK * 2  , STAGE_BYTES = 8 * HTB, NXCD = 8, WGM = 8;

__host__ __device__ __forceinline__ int lds_byte(int r, int c) { const int st = (r >> 4) * 2 + (c >> 5), rr = r & 15, cc = c & 31, ob = rr * 64 + cc * 2; return st * 1024 + (ob ^ (((ob >> 9) & 1) << 5)); }
__host__ __device__ __forceinline__ void stage_rc(int b, int& R, int& C) { const int st = b / 1024, sb = b % 1024, swz = sb ^ (((sb >> 9) & 1) << 5); R = (st >> 1) * 16 + swz / 64; C = (st & 1) * 32 + (swz % 64) / 2; }
__host__ __device__ __forceinline__ int perm32(int rho) { const int n = rho >> 4, i = rho & 15; return 8 * (i >> 2) + 4 * n + (i & 3); }

struct Unit { int pm, pn, sub; };
struct Gemm { int lda, ldb, nt; };

struct Sched {
    int nM, nN, nwg, G, c, subs;
    const char* A; const char* B; size_t a_tile, b_tile, a_sub, b_sub;
    int remap_from = -1, remap_to = 0, i0 = 0, icount = 1 << 30;
    __device__ __forceinline__ bool next(int i, Unit& u) const {
        if (i >= icount) return false; i += i0;
        const int round = (subs == 2) ? (i >> 1) : i; u.sub = (subs == 2) ? (i & 1) : 0;
        const long L = (long)round * G + c; if (L >= nwg) return false;
        int wgid = (int)L; { const int q = nwg / NXCD, r = nwg % NXCD, xcd = wgid % NXCD, off = wgid / NXCD; wgid = (xcd < r ? xcd * (q + 1) : r * (q + 1) + (xcd - r) * q) + off; }
        const int nig = WGM * nN, gid = wgid / nig, fm = gid * WGM, gsz = (nM - fm) < WGM ? (nM - fm) : WGM;
        u.pm = fm + ((wgid % nig) % gsz); u.pn = (wgid % nig) / gsz; if (u.pn == remap_from) u.pn = remap_to; return true;
    }
    __device__ __forceinline__ void ptrs(const Unit& u, const char*& a, const char*& b) const { a = A + (size_t)u.pm * a_tile + (size_t)u.sub * a_sub; b = B + (size_t)u.pn * b_tile + (size_t)u.sub * b_sub; }
    __device__ __forceinline__ const char* xptr(const Unit& u) const { return A + (size_t)nM * a_tile + (size_t)u.pm * (a_tile >> 4) + (size_t)u.sub * a_sub; }
};
struct SchedList {
    int first, stride, total, nM, pn0;
    const char* A; const char* B; size_t a_tile, b_tile;
    __device__ __forceinline__ bool next(int i, Unit& u) const { const int id = first + stride * i; if (id >= total) return false; u.pm = id % nM; u.pn = pn0 + id / nM; u.sub = 0; return true; }
    __device__ __forceinline__ void ptrs(const Unit& u, const char*& a, const char*& b) const { a = A + (size_t)u.pm * a_tile; b = B + (size_t)u.pn * b_tile; }
    __device__ __forceinline__ const char* xptr(const Unit& u) const { return A + (size_t)nM * a_tile + (size_t)u.pm * (a_tile >> 4); }
};

typedef float f32x2_t __attribute__((ext_vector_type(2))); typedef __bf16 bf16x2_t __attribute__((ext_vector_type(2)));
__device__ __forceinline__ unsigned cvt_pk_bf16(float lo, float hi) { f32x2_t v = {lo, hi}; bf16x2_t b = __builtin_convertvector(v, bf16x2_t); return __builtin_bit_cast(unsigned, b); }
__device__ __forceinline__ float bf_lo(unsigned u) { return __uint_as_float(u << 16); }
__device__ __forceinline__ float bf_hi(unsigned u) { return __uint_as_float(u & 0xffff0000u); }

constexpr int XBUF_OFF = 131072 + 4096;
template <bool EX, class Epi, class SchedT>
__device__ __forceinline__ void gemm_phase_t(PG8_LAS unsigned char* lds, const Gemm g, const SchedT& S, const Epi& E) {
    int tid = threadIdx.x; asm volatile("" : "+v"(tid));
    const int wid = __builtin_amdgcn_readfirstlane(tid >> 6), lane = tid & 63, wr = wid >> 2, wc = wid & 3, fr = lane & 15, fq = lane >> 4;
    int nt = g.nt; asm volatile("" : "+s"(nt));
    unsigned voffA[2], voffB[2];
#pragma unroll
    for (int i = 0; i < 2; ++i) { int R, C; stage_rc(tid * 16 + i * 8192, R, C); const int Rb = (R & ~31) + perm32(R & 31);
        voffA[i] = (unsigned)(R * g.lda + C) * 2u; voffB[i] = (unsigned)(Rb * g.ldb + C) * 2u; }
    const size_t kstep = (size_t)(BK * 2);
    const size_t hstepA = (size_t)HALF * g.lda * 2, hstepB = (size_t)HALF * g.ldb * 2;
    const unsigned ldsw = (unsigned)wid * 1024u;
    const int aoff = lds_byte(wr * 64 + fr, fq * 8), boff = lds_byte(wc * 32 + fr, fq * 8);
    unsigned voffX = 0; const int xoff = XBUF_OFF + lds_byte(fr, fq * 8);
    if constexpr (EX) { int R, C; stage_rc(tid * 4, R, C); voffX = (unsigned)(R * g.lda + C) * 2u; }
#define PG8_STAGEX(b, gbase) do { if constexpr (EX) { const char* gb_ = (const char*)(gbase); asm volatile("" : "+s"(gb_)); __builtin_amdgcn_global_load_lds((const unsigned*)(gb_ + voffX), (PG8_LAS unsigned*)(lds + XBUF_OFF + (b) * 2048 + wid * 256), 4, 0, 0); } } while (0)
#define PG8_MMAX1(Bt) do { _Pragma("unroll") for (int n = 0; n < 2; ++n) _Pragma("unroll") for (int k = 0; k < 2; ++k) ex[n] = __builtin_amdgcn_mfma_f32_16x16x32_bf16(Bt[n][k], At[0][k], ex[n], 0, 0, 0); } while (0)
#define PG8_MMA2X(b) do { __builtin_amdgcn_s_setprio(1); \
        _Pragma("unroll") for (int n = 0; n < 2; ++n) _Pragma("unroll") for (int k = 0; k < 2; ++k) acc[1][1][0][n] = __builtin_amdgcn_mfma_f32_16x16x32_bf16(B1[n][k], At[0][k], acc[1][1][0][n], 0, 0, 0); \
        PG8_SCHED; At[0][0] = *(const PG8_LAS bf16x8*)(lds + xoff + (b) * 2048); At[0][1] = *(const PG8_LAS bf16x8*)(lds + xoff + (b) * 2048 + 1024); PG8_SCHED; \
        _Pragma("unroll") for (int m = 1; m < 4; ++m) _Pragma("unroll") for (int n = 0; n < 2; ++n) _Pragma("unroll") for (int k = 0; k < 2; ++k) acc[1][1][m][n] = __builtin_amdgcn_mfma_f32_16x16x32_bf16(B1[n][k], At[m][k], acc[1][1][m][n], 0, 0, 0); \
        PG8_SCHED; if (wr == 0) PG8_MMAX1(B0); else PG8_MMAX1(B1); __builtin_amdgcn_s_setprio(0); } while (0)
#define PG8_WAIT_VK do { if constexpr (EX) PG8_WAIT_V(9); else PG8_WAIT_V(8); } while (0)
#define PG8_SA(b, h) (((b) * 2 + (h)) * HTB)
#define PG8_SB(b, h) ((4 + (b) * 2 + (h)) * HTB)
#define PG8_STAGE(bufoff, gbase, voff) do { const char* gb_ = (const char*)(gbase); asm volatile("" : "+s"(gb_)); _Pragma("unroll") for (int _i = 0; _i < 2; ++_i) \
        __builtin_amdgcn_global_load_lds((const unsigned*)(gb_ + (voff)[_i]), (PG8_LAS unsigned*)(lds + (bufoff) + ldsw + _i * 8192), 16, 0, 0); } while (0)
#define PG8_LDA(dst, b, h) do { _Pragma("unroll") for (int m = 0; m < 4; ++m) _Pragma("unroll") for (int k = 0; k < 2; ++k) dst[m][k] = *(const PG8_LAS bf16x8*)(lds + PG8_SA(b, h) + aoff + m * 2048 + k * 1024); } while (0)
#define PG8_LDB(dst, b, h) do { _Pragma("unroll") for (int n = 0; n < 2; ++n) _Pragma("unroll") for (int k = 0; k < 2; ++k) dst[n][k] = *(const PG8_LAS bf16x8*)(lds + PG8_SB(b, h) + boff + n * 2048 + k * 1024); } while (0)
#define PG8_MMA(ai, bj, At, Bt) do { __builtin_amdgcn_s_setprio(1); _Pragma("unroll") for (int m = 0; m < 4; ++m) _Pragma("unroll") for (int n = 0; n < 2; ++n) _Pragma("unroll") for (int k = 0; k < 2; ++k) \
        acc[ai][bj][m][n] = __builtin_amdgcn_mfma_f32_16x16x32_bf16(Bt[n][k], At[m][k], acc[ai][bj][m][n], 0, 0, 0); __builtin_amdgcn_s_setprio(0); } while (0)
#define PG8_WAIT_V(n) asm volatile("s_waitcnt vmcnt(" #n ")" ::: "memory")
#define PG8_WAIT_L(n) asm volatile("s_waitcnt lgkmcnt(" #n ")" ::: "memory")
#define PG8_BAR __builtin_amdgcn_s_barrier()
#define PG8_SCHED __builtin_amdgcn_sched_barrier(0)
    Unit cur, nxt; int ui = 0;
    if (!S.next(0, cur)) return;
    f32x4 acc[2][2][4][2];
#pragma unroll
    for (int a = 0; a < 2; ++a)
#pragma unroll
        for (int b = 0; b < 2; ++b)
#pragma unroll
            for (int m = 0; m < 4; ++m)
#pragma unroll
                for (int n = 0; n < 2; ++n) acc[a][b][m][n] = (f32x4){0.f, 0.f, 0.f, 0.f};
    bf16x8 At[4][2], B0[2][2], B1[2][2];
    f32x4 ex[2] = {{0.f, 0.f, 0.f, 0.f}, {0.f, 0.f, 0.f, 0.f}};
    const char* cA; const char* cB; S.ptrs(cur, cA, cB);
    const char* cX = cA; if constexpr (EX) cX = S.xptr(cur);
    PG8_STAGE(PG8_SB(0, 0), cB, voffB); PG8_STAGE(PG8_SB(0, 1), cB + hstepB, voffB); PG8_STAGE(PG8_SA(0, 0), cA, voffA); PG8_STAGE(PG8_SA(0, 1), cA + hstepA, voffA); PG8_STAGEX(0, cX);
    if (wr == 1) PG8_BAR;
    if constexpr (EX) PG8_WAIT_V(3); else PG8_WAIT_V(2);
    PG8_BAR;
    PG8_STAGE(PG8_SB(1, 0), cB + kstep, voffB); PG8_STAGE(PG8_SA(1, 0), cA + kstep, voffA); PG8_STAGE(PG8_SB(1, 1), cB + hstepB + kstep, voffB);
    PG8_WAIT_V(6); PG8_BAR;
    for (;;) {
        const bool has_next = S.next(ui + 1, nxt);
        const char* nA = cA; const char* nB = cB; if (has_next) S.ptrs(nxt, nA, nB);
        const char* nX = cX; if constexpr (EX) { if (has_next) nX = S.xptr(nxt); }
        for (int t = 0; t < nt; t += 2) {
            const bool last = (t == nt - 2);
            const char* a1 = cA + (size_t)(t + 1) * kstep;
            const char* a2 = last ? nA : cA + (size_t)(t + 2) * kstep; const char* b2 = last ? nB : cB + (size_t)(t + 2) * kstep;
            const char* a3 = a2 + kstep; const char* b3 = b2 + kstep;
            const char* x1 = cX + (size_t)(t + 1) * kstep; const char* x2 = last ? nX : cX + (size_t)(t + 2) * kstep;
            PG8_LDB(B0, 0, 0); PG8_LDB(B1, 0, 1); PG8_SCHED; PG8_LDA(At, 0, 0); PG8_STAGE(PG8_SA(1, 1), a1 + hstepA, voffA); if (wr == 1) PG8_STAGEX(1, x1);
            PG8_WAIT_VK; PG8_WAIT_L(0); PG8_BAR; PG8_MMA(0, 0, At, B0); PG8_MMA(0, 1, At, B1); PG8_BAR; PG8_SCHED;
            PG8_LDA(At, 0, 1); PG8_STAGE(PG8_SB(0, 0), b2, voffB); PG8_STAGE(PG8_SB(0, 1), b2 + hstepB, voffB); PG8_STAGE(PG8_SA(0, 0), a2, voffA); if (wr == 0) PG8_STAGEX(1, x1);
            PG8_WAIT_VK; PG8_WAIT_L(0); PG8_BAR; PG8_MMA(1, 0, At, B0); if constexpr (EX) PG8_MMA2X(0); else PG8_MMA(1, 1, At, B1); PG8_BAR; PG8_SCHED;
            PG8_LDB(B0, 1, 0); PG8_LDB(B1, 1, 1); PG8_SCHED; PG8_LDA(At, 1, 0); PG8_STAGE(PG8_SA(0, 1), a2 + hstepA, voffA); if (wr == 1) PG8_STAGEX(0, x2);
            PG8_WAIT_VK; PG8_WAIT_L(0); PG8_BAR; PG8_MMA(0, 0, At, B0); PG8_MMA(0, 1, At, B1); PG8_BAR; PG8_SCHED;
            PG8_LDA(At, 1, 1); PG8_STAGE(PG8_SB(1, 0), b3, voffB); PG8_STAGE(PG8_SB(1, 1), b3 + hstepB, voffB); PG8_STAGE(PG8_SA(1, 0), a3, voffA); if (wr == 0) PG8_STAGEX(0, x2);
            PG8_WAIT_VK; PG8_WAIT_L(0); PG8_BAR; PG8_MMA(1, 0, At, B0); if constexpr (EX) PG8_MMA2X(1); else PG8_MMA(1, 1, At, B1); PG8_BAR; PG8_SCHED;
        }
        if (wr == 0) PG8_BAR;
        bool zero; int efr = fr, efq = fq; asm volatile("" : "+v"(efr), "+v"(efq));
        if constexpr (EX) zero = E(acc, ex, cur, wr, wc, efr, efq); else zero = E(acc, cur, wr, wc, efr, efq);
        if (!has_next) break;
        if (zero) {
#pragma unroll
        for (int a = 0; a < 2; ++a)
#pragma unroll
            for (int b = 0; b < 2; ++b)
#pragma unroll
                for (int m = 0; m < 4; ++m)
#pragma unroll
                    for (int n = 0; n < 2; ++n) acc[a][b][m][n] = (f32x4){0.f, 0.f, 0.f, 0.f};
            ex[0] = (f32x4){0.f, 0.f, 0.f, 0.f}; ex[1] = (f32x4){0.f, 0.f, 0.f, 0.f};
        }
        cur = nxt; cA = nA; cB = nB; cX = nX; ++ui;
        if (wr == 1) PG8_BAR;
    }
    PG8_WAIT_V(0);
    PG8_BAR;
#undef PG8_SA
#undef PG8_SB
#undef PG8_STAGE
#undef PG8_STAGEX
#undef PG8_MMAX1
#undef PG8_MMA2X
#undef PG8_WAIT_VK
#undef PG8_LDA
#undef PG8_LDB
#undef PG8_MMA
#undef PG8_WAIT_V
#undef PG8_WAIT_L
#undef PG8_BAR
#undef PG8_SCHED
}
template <class Epi, class SchedT>
__device__ __forceinline__ void gemm_phase(PG8_LAS unsigned char* lds, const Gemm g, const SchedT& S, const Epi& E) { gemm_phase_t<false>(lds, g, S, E); }
}

constexpr int NWAVES = 8;
constexpr int DM = 2048, NPROMPT = 8192, NSAMPLE = 512, MTOT = NPROMPT + NSAMPLE;
constexpr int SEQ = 2048, DECB = 128, DECS = 4, PLE = 256, DFF = 5632;
constexpr int HGH = 8, GLH = 4;
constexpr int INCOLS = 11280, LDZ = 11264, N1PAD = 11520;
constexpr int ZC_HQ = 0, ZC_HK = 1024, ZC_HV = 2048, ZC_HG = 3072, ZC_GQ = 4096, ZC_GK = 4608, ZC_GV = 5120, ZC_GG = 6144, ZC_MG = 7168;
constexpr float EPS = 1e-6f, SQK = 0.08838834764831845f;

constexpr size_t MiB = 1u << 20;
constexpr size_t WS_CTL = 0, CTL_ZERO_BYTES = 256 * 1024;
constexpr size_t WS_WIN = 2 * MiB, WS_WB = 47 * MiB, WS_WOUT = 55 * MiB, WS_WGU = 63 * MiB, WS_WDN = 107 * MiB, WS_WPG = 129 * MiB, WS_WPLE = 137 * MiB;
constexpr size_t WS_PB = 138 * MiB;
constexpr size_t WS_RSTD1 = 143 * MiB, WS_GLR = WS_RSTD1 + 64 * 1024, WS_SS2 = 144 * MiB, WS_SS3 = WS_SS2 + 1280 * 1024, WS_SSF = WS_SS3 + 1280 * 1024;
constexpr size_t WS_SSFX = WS_SSF + 1152 * 1024;
constexpr size_t WS_BUFA = 148 * MiB, WS_BUFB = 182 * MiB;
constexpr size_t WS_LOGF = 216 * MiB;
constexpr size_t WS_Z = 250 * MiB;
constexpr size_t WS_PLEF = WS_LOGF;
constexpr size_t WS_AD = 437 * MiB;
constexpr size_t WS_END = 447 * MiB;
static_assert(WS_WIN + (size_t)N1PAD * DM * 2 <= WS_WB && WS_WGU + (size_t)2 * DFF * DM * 2 <= WS_WDN && WS_WDN + (size_t)DM * DFF * 2 <= WS_WPG && WS_PB + (size_t)MTOT * PLE * 2 <= WS_RSTD1, "ws map 1");
static_assert(WS_GLR + (size_t)MTOT * 16 * 4 <= WS_SS2 && WS_SSF + (size_t)MTOT * 32 * 4 <= WS_SSFX && WS_SSFX + (size_t)8 * NSAMPLE * 8 * 4 <= WS_BUFA && WS_BUFA + (size_t)MTOT * DM * 2 <= WS_BUFB && WS_BUFB + (size_t)MTOT * DM * 2 <= WS_LOGF, "ws map 2");
static_assert(WS_LOGF + (size_t)MTOT * 1024 * 4 <= WS_Z && WS_Z + (size_t)MTOT * LDZ * 2 <= WS_END && (size_t)MTOT * DFF * 2 <= 96 * MiB && WS_PLEF + (size_t)MTOT * DM * 2 <= WS_Z, "ws map 3");
constexpr size_t OUT_Y = 0, OUT_HP = (size_t)MTOT * DM, OUT_GP = OUT_HP + 4 * 8 * 128 * 128, OUT_HS = OUT_GP + 4 * 4 * 128 * 256, OUT_GS = OUT_HS + (size_t)128 * 8 * 128 * 128, OUT_END = OUT_GS + (size_t)128 * 4 * 128 * 256;
constexpr int CW_PSUB = 2048;
constexpr int CW_XCC = 1024;
constexpr int CW_PRE = 512;
constexpr int CW_Q = 64;
constexpr int CW_BAR = 4096;
constexpr int CW_PB3 = 12288, CW_PB6 = 16384;
constexpr int CW_PAN = 8192;

constexpr int RING_OFF = 0, RING_BYTES = 131072;
constexpr int LDSCTL_OFF = RING_BYTES, MISC_OFF = LDSCTL_OFF + 320;
constexpr int XS_OFF = pg8::XBUF_OFF + 4096;
constexpr int LDS_BYTES = 147456;

#define GAS __attribute__((address_space(1)))
#define LAS __attribute__((address_space(3)))
typedef unsigned short bf16;
typedef unsigned v4u __attribute__((ext_vector_type(4)));
typedef unsigned v2u __attribute__((ext_vector_type(2)));
typedef float f32x4 __attribute__((ext_vector_type(4)));
typedef short bf16x8 __attribute__((ext_vector_type(8)));
typedef short s16x4 __attribute__((ext_vector_type(4)));
typedef GAS unsigned gu32;
#define RLX_AGENT __ATOMIC_RELAXED, __HIP_MEMORY_SCOPE_AGENT
#define LDS_WAIT() asm volatile("s_waitcnt lgkmcnt(0)" ::: "memory")
#define VM_WAIT() asm volatile("s_waitcnt vmcnt(0)" ::: "memory")
__device__ __forceinline__ unsigned f2bf(float f) { unsigned u = __builtin_bit_cast(unsigned, f); return (u + 0x7fffu + ((u >> 16) & 1u)) >> 16; }
__device__ __forceinline__ unsigned pk2(float lo, float hi) { return f2bf(lo) | (f2bf(hi) << 16); }
__device__ __forceinline__ float bf2f(bf16 b) { return __uint_as_float((unsigned)b << 16); }
__device__ __forceinline__ float sigm(float v) { return __builtin_amdgcn_rcpf(1.f + __expf(-v)); }

#define XB_TMO      128
#define XB_XCNT(j)  (256  + 64 * (j))
#define XB_XSUB(j)  (1280 + 64 * (j))
#define XB_XGEN(j)  (2304 + 64 * (j))
#define XB_TOP      3328
#define XB_TOPGEN   3392
#define XCD_BAR_WORDS 3456
#define XB_SPIN_CAP (1u << 18)
__device__ __forceinline__ unsigned xb_ld(unsigned* p)              { return __hip_atomic_load(p, __ATOMIC_RELAXED, __HIP_MEMORY_SCOPE_AGENT); }
__device__ __forceinline__ unsigned xb_add(unsigned* p, unsigned v) { return __hip_atomic_fetch_add(p, v, __ATOMIC_RELAXED, __HIP_MEMORY_SCOPE_AGENT); }
__device__ __forceinline__ unsigned xb_xcc_id() { return (unsigned)__builtin_amdgcn_s_getreg((3 << 11) | 20) & 0xFu; }
#define XB_SPIN(cond, bar) do { unsigned _sp = 0; while (cond) { __builtin_amdgcn_s_sleep(1); \
    if ((++_sp & 255u) == 0u) { if (xb_ld(&(bar)[XB_TMO])) break; if (_sp > XB_SPIN_CAP) { atomicAdd(&(bar)[XB_TMO], 1u); break; } } } } while (0)
struct XcdBarrier { unsigned* bar; unsigned x; volatile LAS unsigned* st; };
__device__ __forceinline__ XcdBarrier xcd_barrier_post(unsigned* bar, volatile LAS unsigned* st) {
    XcdBarrier b; b.bar = bar; b.x = xb_xcc_id(); b.st = st;
    if (threadIdx.x == 0) (void)xb_add(&bar[XB_XCNT(b.x)], 1u);
    return b;
}
__device__ __forceinline__ void xcd_barrier_complete(unsigned* bar, unsigned x, unsigned& nloc, unsigned& nx) {
    const unsigned G = gridDim.x * gridDim.y * gridDim.z;
    unsigned sum, cnt, mine, sp = 0u;
    for (;;) {
        sum = 0u; cnt = 0u; mine = 0u;
#pragma unroll
        for (unsigned j = 0; j < 16; ++j) { const unsigned c = xb_ld(&bar[XB_XCNT(j)]); sum += c; cnt += (c > 0u) ? 1u : 0u; mine = (j == x) ? c : mine; }
        if (sum == G) break;
        __builtin_amdgcn_s_sleep(1);
        if ((++sp & 255u) == 0u) { if (xb_ld(&bar[XB_TMO])) break; if (sp > XB_SPIN_CAP) { atomicAdd(&bar[XB_TMO], 1u); break; } }
    }
    nloc = mine > 0u ? mine : 1u; nx = cnt > 0u ? cnt : 1u;
}
__device__ __forceinline__ void xcd_barrier(const XcdBarrier& b) {
    asm volatile("s_waitcnt vmcnt(0)" ::: "memory");
    __syncthreads();
    if (threadIdx.x == 0) {
        unsigned* bar = b.bar;
        __builtin_amdgcn_s_waitcnt(0);
        unsigned nloc = b.st[0], nx = b.st[1];
        if (nloc == 0u) { xcd_barrier_complete(bar, b.x, nloc, nx); b.st[0] = nloc; b.st[1] = nx; }
        const unsigned old = xb_add(&bar[XB_XSUB(b.x)], 1u);
        const unsigned gen = old / nloc;
        if (old + 1u == (gen + 1u) * nloc) {
            __builtin_amdgcn_fence(__ATOMIC_RELEASE, "agent");
            asm volatile("s_waitcnt vmcnt(0)" ::: "memory");
            const unsigned og = xb_add(&bar[XB_TOP], 1u);
            const unsigned tg = og / nx;
            if (og + 1u == (tg + 1u) * nx) xb_add(&bar[XB_TOPGEN], 1u);
            else XB_SPIN(xb_ld(&bar[XB_TOPGEN]) == tg, bar);
            __builtin_amdgcn_fence(__ATOMIC_ACQUIRE, "agent");
            xb_add(&bar[XB_XGEN(b.x)], 1u);
            asm volatile("s_waitcnt vmcnt(0)" ::: "memory");
        } else {
            XB_SPIN(xb_ld(&bar[XB_XGEN(b.x)]) == gen, bar);
            __builtin_amdgcn_fence(__ATOMIC_ACQUIRE, "agent");
            asm volatile("s_waitcnt vmcnt(0)" ::: "memory");
        }
    }
    __syncthreads();
}

__device__ __forceinline__ void grid_barrier(gu32* w, unsigned epoch, int G, int bx, int xcc = -1) {
    asm volatile("s_waitcnt vmcnt(0)" ::: "memory");
    __syncthreads();
    if (threadIdx.x == 0) {
        if (xcc < 0) { __builtin_amdgcn_fence(__ATOMIC_RELEASE, "agent"); asm volatile("s_waitcnt vmcnt(0)" ::: "memory"); }
        const bool two = (G % 8) == 0; const int g = two ? (xcc >= 0 ? xcc : (bx & 7)) : 0; const unsigned nloc = two ? (unsigned)(G / 8) : (unsigned)G, ngrp = two ? 8u : 1u;
        gu32* sub = w + 64 * g; gu32* gen = w + 64 * (8 + g); gu32* top = w + 64 * 16; gu32* topgen = w + 64 * 17;
        unsigned sp = 0;
        if (__hip_atomic_fetch_add(sub, 1u, RLX_AGENT) + 1u == epoch * nloc) {
            if (xcc >= 0) { __builtin_amdgcn_fence(__ATOMIC_RELEASE, "agent"); asm volatile("s_waitcnt vmcnt(0)" ::: "memory"); }
            if (__hip_atomic_fetch_add(top, 1u, RLX_AGENT) + 1u == epoch * ngrp) __hip_atomic_fetch_add(topgen, 1u, RLX_AGENT);
            else while (__hip_atomic_load(topgen, RLX_AGENT) < epoch && ++sp < (1u << 24)) __builtin_amdgcn_s_sleep(2);
            __hip_atomic_fetch_add(gen, 1u, RLX_AGENT);
        } else while (__hip_atomic_load(gen, RLX_AGENT) < epoch && ++sp < (1u << 24)) __builtin_amdgcn_s_sleep(4);
        __builtin_amdgcn_fence(__ATOMIC_ACQUIRE, "agent");
        asm volatile("s_waitcnt vmcnt(0)" ::: "memory");
    }
    __syncthreads();
}

__device__ __forceinline__ void panel_barrier(gu32* c, unsigned n, bool release = true) {
    asm volatile("s_waitcnt vmcnt(0)" ::: "memory");
    __syncthreads();
    if (threadIdx.x == 0) {
        if (release) { __builtin_amdgcn_fence(__ATOMIC_RELEASE, "agent"); asm volatile("s_waitcnt vmcnt(0)" ::: "memory"); }
        unsigned sp = 0;
        if (__hip_atomic_fetch_add(c, 1u, RLX_AGENT) + 1u < n) while (__hip_atomic_load(c, RLX_AGENT) < n && ++sp < (1u << 24)) __builtin_amdgcn_s_sleep(2);
        __builtin_amdgcn_fence(__ATOMIC_ACQUIRE, "agent");
        asm volatile("s_waitcnt vmcnt(0)" ::: "memory");
    }
    __syncthreads();
}

__device__ __forceinline__ void cnt_arrive(gu32* c) {
    asm volatile("s_waitcnt vmcnt(0)" ::: "memory");
    __syncthreads();
    if (threadIdx.x == 0) { __builtin_amdgcn_fence(__ATOMIC_RELEASE, "agent"); asm volatile("s_waitcnt vmcnt(0)" ::: "memory"); __hip_atomic_fetch_add(c, 1u, RLX_AGENT); }
}
__device__ __forceinline__ void cnt_arrive_x(gu32* c, gu32* sub, int xcc, unsigned nloc) {
    if (xcc < 0) { cnt_arrive(c); return; }
    asm volatile("s_waitcnt vmcnt(0)" ::: "memory");
    __syncthreads();
    if (threadIdx.x == 0 && __hip_atomic_fetch_add(sub + 64 * xcc, 1u, RLX_AGENT) + 1u == nloc) {
        __builtin_amdgcn_fence(__ATOMIC_RELEASE, "agent"); asm volatile("s_waitcnt vmcnt(0)" ::: "memory"); __hip_atomic_fetch_add(c, 1u, RLX_AGENT); }
}
__device__ __forceinline__ void cnt_wait(gu32* c, unsigned n) {
    if (threadIdx.x == 0) { unsigned sp = 0;
        while (__hip_atomic_load(c, RLX_AGENT) < n && ++sp < (1u << 24)) __builtin_amdgcn_s_sleep(2);
        __builtin_amdgcn_fence(__ATOMIC_ACQUIRE, "agent"); asm volatile("s_waitcnt vmcnt(0)" ::: "memory"); }
    __syncthreads();
}

__device__ __forceinline__ float wave_sum(float v) {
#pragma unroll
    for (int o = 1; o < 64; o <<= 1) v += __shfl_xor(v, o);
    return v;
}
template <int MODE> __device__ __forceinline__ int dest_row(int n) {
    if (MODE == 1) return n < 7168 ? n : (n < 7184 ? n + 4096 : n - 16);
    if (MODE == 2) { const int up = n >= DFF ? 1 : 0, j = n - up * DFF; return 256 * (j >> 7) + 128 * up + (j & 127); }
    return n;
}
template <int MODE> __device__ __forceinline__ void p0_transpose_item(const float* W, int K, int N, const float* kscale, bf16* WT, LAS float* scr, int item, int lane) {
    const int nblk = (N + 31) / 32, kb = item / nblk, nb = item % nblk, k0 = 64 * kb, n0 = 32 * nb;
    const int nl = n0 + (lane & 31); const bool nok = nl < N;
#pragma unroll 8
    for (int i = 0; i < 32; ++i) { const int kk = 2 * i + (lane >> 5); float v = nok ? W[(size_t)(k0 + kk) * N + nl] : 0.f; if (kscale) v *= kscale[k0 + kk]; scr[kk * 33 + (lane & 31)] = v; }
    LDS_WAIT(); asm volatile("" ::: "memory");
    const int c = lane & 7;
#pragma unroll
    for (int j = 0; j < 4; ++j) { const int n = (lane >> 3) + 8 * j; const LAS float* s = scr + (8 * c) * 33 + n;
        v4u o; o.x = pk2(s[0 * 33], s[1 * 33]); o.y = pk2(s[2 * 33], s[3 * 33]); o.z = pk2(s[4 * 33], s[5 * 33]); o.w = pk2(s[6 * 33], s[7 * 33]);
        if (n0 + n < N) *(GAS v4u*)(WT + (size_t)dest_row<MODE>(n0 + n) * K + k0 + 8 * c) = o; }
    LDS_WAIT(); asm volatile("" ::: "memory");
}

struct P0Mat { const float* W; const float* kscale; bf16* WT; int K, N, mode, tiles; };
__device__ __forceinline__ int dest_row_rt(int mode, int n) { return mode == 1 ? dest_row<1>(n) : (mode == 2 ? dest_row<2>(n) : n); }
__device__ __forceinline__ void p0_tile_load(const P0Mat& m, int tile, f32x4 (&v)[8], int tid) {
    const int ntn = (m.N + 255) >> 8, kb = tile / ntn, nb = tile - kb * ntn, k0 = 64 * kb, n0 = 256 * nb;
#pragma unroll
    for (int i = 0; i < 4; ++i) { const int idx = tid + 512 * i, rp = idx >> 6, n = n0 + 4 * (idx & 63); const float* p = m.W + (size_t)(k0 + 2 * rp) * m.N + n;
        if (n < m.N) { v[2 * i] = *(const GAS f32x4*)p; v[2 * i + 1] = *(const GAS f32x4*)(p + m.N); } else { v[2 * i] = (f32x4){0.f, 0.f, 0.f, 0.f}; v[2 * i + 1] = v[2 * i]; } }
}
__device__ __forceinline__ void p0_tile_store(const P0Mat& m, int tile, const f32x4 (&v)[8], LAS unsigned* img, int tid) {
    const int ntn = (m.N + 255) >> 8, kb = tile / ntn, nb = tile - kb * ntn, k0 = 64 * kb, n0 = 256 * nb;
#pragma unroll
    for (int i = 0; i < 4; ++i) { const int idx = tid + 512 * i, rp = idx >> 6, c4 = idx & 63;
        const float s0 = m.kscale ? m.kscale[k0 + 2 * rp] : 1.f, s1 = m.kscale ? m.kscale[k0 + 2 * rp + 1] : 1.f;
#pragma unroll
        for (int j = 0; j < 4; ++j) img[(4 * c4 + j) * 33 + rp] = pg8::cvt_pk_bf16(v[2 * i][j] * s0, v[2 * i + 1][j] * s1); }
    __syncthreads();
#pragma unroll
    for (int i = 0; i < 4; ++i) { const int idx = tid + 512 * i, n = idx >> 3, c = idx & 7; const LAS unsigned* q = img + n * 33 + 4 * c;
        const v4u o = (v4u){q[0], q[1], q[2], q[3]};
        if (n0 + n < m.N) *(GAS v4u*)(m.WT + (size_t)dest_row_rt(m.mode, n0 + n) * m.K + k0 + 8 * c) = o; }
    __syncthreads();
}

namespace epi {
using pg8::Unit; using pg8::cvt_pk_bf16; using pg8::bf_lo; using pg8::bf_hi;
typedef pg8::f32x4 f4; typedef pg8::u32x4 u4;
#define EPI_ROWS for (int ai = 0; ai < 2; ++ai) _Pragma("unroll") for (int m = 0; m < 4; ++m)
template <int T> __device__ __forceinline__ float act1(float v) {
    if (T == 2) return v;
    if (T == 4) return v * SQK;
    const float s = sigm(v);
    if (T == 0) return v * s * SQK;
    if (T == 3) return v * s;
    return s;
}
__device__ __forceinline__ __amdgpu_buffer_rsrc_t wt_rsrc(const void* base, size_t bytes) { return __builtin_amdgcn_make_buffer_rsrc((void*)base, (short)0, (int)bytes, 0x00020000); }
__device__ __forceinline__ void wt_store16(const __amdgpu_buffer_rsrc_t r, size_t elem_off_bf16, const u4& v) { __builtin_amdgcn_raw_buffer_store_b128(v, r, (unsigned)(elem_off_bf16 * 2), 0,   16); }
__device__ __forceinline__ u4 pack8(const f4& a, const f4& b) { u4 w; w.x = cvt_pk_bf16(a[0], a[1]); w.y = cvt_pk_bf16(a[2], a[3]); w.z = cvt_pk_bf16(b[0], b[1]); w.w = cvt_pk_bf16(b[2], b[3]); return w; }
struct Epi1 {
    bf16* Z; float* LOGF; float* GLR; const float* rstd; const float* hg_lb;
    template <int T> __device__ __forceinline__ void plain(const f4 (&acc)[2][2][4][2], int row0, int col0) const {
#pragma unroll
        EPI_ROWS { const int row = row0 + ai * 128 + m * 16; const float rs = rstd[row];
#pragma unroll
            for (int bj = 0; bj < 2; ++bj) { f4 a = acc[ai][bj][m][0] * rs, b = acc[ai][bj][m][1] * rs;
#pragma unroll
                for (int i = 0; i < 4; ++i) { a[i] = act1<T>(a[i]); b[i] = act1<T>(b[i]); }
                *(u4*)(Z + (size_t)row * LDZ + col0 + bj * 128) = pack8(a, b); } }
    }
    __device__ __forceinline__ bool operator()(f4 (&acc)[2][2][4][2], const Unit& u, int wr, int wc, int fr, int fq) const {
        const int pn = u.pn, row0 = u.pm * 256 + wr * 64 + fr, col0 = pn * 256 + wc * 32 + 8 * fq;
        if (pn < 4) plain<0>(acc, row0, col0);
        else if (pn < 8) {
            float lb[2][8];
#pragma unroll
            for (int bj = 0; bj < 2; ++bj)
#pragma unroll
                for (int i = 0; i < 8; ++i) { const int c = col0 - ZC_HK + bj * 128 + i; lb[bj][i] = __builtin_amdgcn_rcpf(1.f + __expf(hg_lb[1024 + c] - hg_lb[c])); }
#pragma unroll
            EPI_ROWS { const int row = row0 + ai * 128 + m * 16; const float rs = rstd[row];
#pragma unroll
                for (int bj = 0; bj < 2; ++bj) { f4 lf[2], kk[2];
#pragma unroll
                    for (int n = 0; n < 2; ++n)
#pragma unroll
                        for (int i = 0; i < 4; ++i) { const float z = fminf(fmaxf(acc[ai][bj][m][n][i] * rs, -80.f), 80.f), e = __expf(-z), r = __builtin_amdgcn_rcpf(1.f + e);
                            const float l = lb[bj][4 * n + i], om = 1.f - l; lf[n][i] = __logf(l + om * r); kk[n][i] = om * (e * r); }
                    const int c = col0 + bj * 128;
                    *(u4*)(Z + (size_t)row * LDZ + c) = pack8(kk[0], kk[1]);
                    float* lp = LOGF + (size_t)row * 1024 + (c - ZC_HK); *(f4*)lp = lf[0]; *(f4*)(lp + 4) = lf[1]; } }
        }
        else if (pn < 12) plain<2>(acc, row0, col0);
        else if (pn < 16) plain<3>(acc, row0, col0);
        else if (pn < 18) plain<4>(acc, row0, col0);
        else if (pn < 24) plain<2>(acc, row0, col0);
        else if (pn < 28) plain<3>(acc, row0, col0);
        else if (pn < 44) plain<5>(acc, row0, col0);
        else if (wc == 0 && fq < 2) {
#pragma unroll
            EPI_ROWS { const int row = row0 + ai * 128 + m * 16; const float rs = rstd[row]; float* gp = GLR + (size_t)row * 16 + 8 * fq;
                *(f4*)gp = acc[ai][0][m][0] * rs; *(f4*)(gp + 4) = acc[ai][0][m][1] * rs; }
        }
        return true;
    }
};
struct Epi2 {
    const bf16* Z; bf16* MG;
    __device__ __forceinline__ bool operator()(f4 (&acc)[2][2][4][2], const Unit& u, int wr, int wc, int fr, int fq) const {
        const int row0 = u.pm * 256 + wr * 64 + fr, col0 = u.pn * 256 + wc * 32 + 8 * fq;
        const __amdgpu_buffer_rsrc_t mgr = wt_rsrc(MG, (size_t)MTOT * DM * 2);
#pragma unroll
        EPI_ROWS { const int row = row0 + ai * 128 + m * 16;
#pragma unroll
            for (int bj = 0; bj < 2; ++bj) { const int c = col0 + bj * 128; const bf16* gp = Z + (size_t)row * LDZ + ZC_MG + c;
                const u4 g1 = *(const u4*)(gp + DM);
                f4 h0 = (f4){bf_lo(g1.x), bf_hi(g1.x), bf_lo(g1.y), bf_hi(g1.y)}, h1 = (f4){bf_lo(g1.z), bf_hi(g1.z), bf_lo(g1.w), bf_hi(g1.w)};
                if (u.sub == 0) { const u4 g0 = *(const u4*)gp;
                    const f4 q0 = (f4){bf_lo(g0.x), bf_hi(g0.x), bf_lo(g0.y), bf_hi(g0.y)}, q1 = (f4){bf_lo(g0.z), bf_hi(g0.z), bf_lo(g0.w), bf_hi(g0.w)};
#pragma unroll
                    for (int i = 0; i < 4; ++i) { acc[ai][bj][m][0][i] *= q0[i] * __builtin_amdgcn_rcpf(h0[i]); acc[ai][bj][m][1][i] *= q1[i] * __builtin_amdgcn_rcpf(h1[i]); }
                } else wt_store16(mgr, (size_t)row * DM + c, pack8(acc[ai][bj][m][0] * h0, acc[ai][bj][m][1] * h1));
            } }
        return u.sub != 0;
    }
    __device__ __forceinline__ bool operator()(f4 (&acc)[2][2][4][2], f4 (&ex)[2], const Unit& u, int wr, int wc, int fr, int fq) const {
        { const int row = NPROMPT + 16 * u.pm + fr, c = u.pn * 256 + wr * 128 + wc * 32 + 8 * fq; const bf16* gp = Z + (size_t)row * LDZ + ZC_MG + c;
          const u4 g1 = *(const u4*)(gp + DM);
          f4 h0 = (f4){bf_lo(g1.x), bf_hi(g1.x), bf_lo(g1.y), bf_hi(g1.y)}, h1 = (f4){bf_lo(g1.z), bf_hi(g1.z), bf_lo(g1.w), bf_hi(g1.w)};
          if (u.sub == 0) { const u4 g0 = *(const u4*)gp;
              const f4 q0 = (f4){bf_lo(g0.x), bf_hi(g0.x), bf_lo(g0.y), bf_hi(g0.y)}, q1 = (f4){bf_lo(g0.z), bf_hi(g0.z), bf_lo(g0.w), bf_hi(g0.w)};
#pragma unroll
              for (int i = 0; i < 4; ++i) { ex[0][i] *= q0[i] * __builtin_amdgcn_rcpf(h0[i]); ex[1][i] *= q1[i] * __builtin_amdgcn_rcpf(h1[i]); }
          } else wt_store16(wt_rsrc(MG, (size_t)MTOT * DM * 2), (size_t)row * DM + c, pack8(ex[0] * h0, ex[1] * h1)); }
        return (*this)(acc, u, wr, wc, fr, fq);
    }
};
template <bool RES_BF16> struct EpiRes {
    const float* res_p; const float* res_s; const bf16* res_b; bf16* XB; float* SS;
    __device__ __forceinline__ bool operator()(f4 (&acc)[2][2][4][2], const Unit& u, int wr, int wc, int fr, int fq) const {
        const int row0 = u.pm * 256 + wr * 64 + fr, col0 = u.pn * 256 + wc * 32 + 8 * fq;
        const float* rb = u.pm < 32 ? res_p : res_s - (size_t)NPROMPT * DM;
        const __amdgpu_buffer_rsrc_t xbr = wt_rsrc(XB, (size_t)MTOT * DM * 2);
#pragma unroll
        EPI_ROWS { const int row = row0 + ai * 128 + m * 16; float ssq = 0.f;
#pragma unroll
            for (int bj = 0; bj < 2; ++bj) { const size_t off = (size_t)row * DM + col0 + bj * 128;
                f4 r0, r1;
                if (RES_BF16) { const u4 w = *(const u4*)(res_b + off); r0 = (f4){bf_lo(w.x), bf_hi(w.x), bf_lo(w.y), bf_hi(w.y)}; r1 = (f4){bf_lo(w.z), bf_hi(w.z), bf_lo(w.w), bf_hi(w.w)}; }
                else { r0 = *(const f4*)(rb + off); r1 = *(const f4*)(rb + off + 4); }
                const f4 o0 = acc[ai][bj][m][0] + r0, o1 = acc[ai][bj][m][1] + r1;
                wt_store16(xbr, off, pack8(o0, o1));
                ssq += (o0[0] * o0[0] + o0[1] * o0[1]) + (o0[2] * o0[2] + o0[3] * o0[3]) + (o1[0] * o1[0] + o1[1] * o1[1]) + (o1[2] * o1[2] + o1[3] * o1[3]); }
            ssq += __shfl_xor(ssq, 16); ssq += __shfl_xor(ssq, 32);
            if (fq == 0) __hip_atomic_store((unsigned*)(SS + ((size_t)u.pn * MTOT + row) * 4 + wc), __float_as_uint(ssq), __ATOMIC_RELAXED, __HIP_MEMORY_SCOPE_AGENT); }
        return true;
    }
    LAS float* xs;
    __device__ __forceinline__ bool operator()(f4 (&acc)[2][2][4][2], f4 (&ex)[2], const Unit& u, int wr, int wc, int fr, int fq) const {
        const int row = NPROMPT + 16 * u.pm + fr; const size_t off = (size_t)row * DM + u.pn * 256 + wr * 128 + wc * 32 + 8 * fq;
        f4 r0, r1;
        if (RES_BF16) { const u4 w = *(const u4*)(res_b + off); r0 = (f4){bf_lo(w.x), bf_hi(w.x), bf_lo(w.y), bf_hi(w.y)}; r1 = (f4){bf_lo(w.z), bf_hi(w.z), bf_lo(w.w), bf_hi(w.w)}; }
        else { const float* rp = res_s + (off - (size_t)NPROMPT * DM); r0 = *(const f4*)rp; r1 = *(const f4*)(rp + 4); }
        const f4 o0 = ex[0] + r0, o1 = ex[1] + r1;
        wt_store16(wt_rsrc(XB, (size_t)MTOT * DM * 2), off, pack8(o0, o1));
        float sx = (o0[0] * o0[0] + o0[1] * o0[1]) + (o0[2] * o0[2] + o0[3] * o0[3]) + (o1[0] * o1[0] + o1[1] * o1[1]) + (o1[2] * o1[2] + o1[3] * o1[3]);
        sx += __shfl_xor(sx, 16); sx += __shfl_xor(sx, 32);
        if (wr == 1 && fq == 0) xs[wc * 16 + fr] = sx;
        asm volatile("s_waitcnt lgkmcnt(0)" ::: "memory"); __builtin_amdgcn_s_barrier(); asm volatile("" ::: "memory");
        if (wr == 0 && fq == 0) __hip_atomic_store((unsigned*)(SS + ((size_t)u.pn * MTOT + row) * 4 + wc), __float_as_uint(sx + xs[wc * 16 + fr]), __ATOMIC_RELAXED, __HIP_MEMORY_SCOPE_AGENT);
        return (*this)(acc, u, wr, wc, fr, fq);
    }
};
__device__ __forceinline__ float row_rstd(const float* SS, int row, int fq) {
    const f4 a = *(const f4*)(SS + ((size_t)(2 * fq) * MTOT + row) * 4), b = *(const f4*)(SS + ((size_t)(2 * fq + 1) * MTOT + row) * 4);
    float s = ((a[0] + a[1]) + (a[2] + a[3])) + ((b[0] + b[1]) + (b[2] + b[3]));
    s += __shfl_xor(s, 16); s += __shfl_xor(s, 32);
    return __builtin_amdgcn_rsqf(s * (1.f / DM) + EPS);
}
struct EpiPle {
    bf16* PLEF;
    __device__ __forceinline__ bool operator()(f4 (&acc)[2][2][4][2], const Unit& u, int wr, int wc, int fr, int fq) const {
        const int row0 = u.pm * 256 + wr * 64 + fr, col0 = u.pn * 256 + wc * 32 + 8 * fq;
#pragma unroll
        EPI_ROWS { const int row = row0 + ai * 128 + m * 16;
#pragma unroll
            for (int bj = 0; bj < 2; ++bj) { *(u4*)(PLEF + (size_t)row * (2 * DM) + u.pn * 512 + (col0 - u.pn * 256) + bj * 128) = pack8(acc[ai][bj][m][0], acc[ai][bj][m][1]); asm volatile("" ::: "memory"); } }
        return true;
    }
    __device__ __forceinline__ bool operator()(f4 (&acc)[2][2][4][2], f4 (&ex)[2], const Unit& u, int wr, int wc, int fr, int fq) const {
        *(u4*)(PLEF + (size_t)(NPROMPT + 16 * u.pm + fr) * (2 * DM) + u.pn * 512 + wr * 128 + wc * 32 + 8 * fq) = pack8(ex[0], ex[1]); asm volatile("" ::: "memory");
        return (*this)(acc, u, wr, wc, fr, fq);
    }
};
struct Epi4 {
    const float* SS; bf16* ACT;
    __device__ __forceinline__ bool operator()(f4 (&acc)[2][2][4][2], const Unit& u, int wr, int wc, int fr, int fq) const {
        const int row0 = u.pm * 256 + wr * 64 + fr, col0 = u.pn * 128 + wc * 32 + 8 * fq;
#pragma unroll
        EPI_ROWS { const int row = row0 + ai * 128 + m * 16; const float rs = row_rstd(SS, row, fq); f4 o[2];
#pragma unroll
            for (int n = 0; n < 2; ++n)
#pragma unroll
                for (int i = 0; i < 4; ++i) { const float gt = acc[ai][0][m][n][i] * rs, up = acc[ai][1][m][n][i] * rs; o[n][i] = gt * sigm(gt) * up; }
            *(u4*)(ACT + (size_t)row * DFF + col0) = pack8(o[0], o[1]); }
        return true;
    }
};
struct Epi6 {
    const float* SS; const bf16* PLEF; const bf16* XB; float* XR; float* SSF; float* SSFX; const float* lnf; unsigned* cnt;
    __device__ __forceinline__ bool operator()(f4 (&acc)[2][2][4][2], f4 (&ex)[2], const Unit& u, int wr, int wc, int fr, int fq) const {
        const int row0 = u.pm * 256 + wr * 64 + fr, col0 = u.pn * 256 + wc * 32 + 8 * fq;
        const int rowx = NPROMPT + 16 * u.pm + fr, colx = u.pn * 256 + wr * 128 + wc * 32 + 8 * fq;
#pragma unroll
        EPI_ROWS { const int row = row0 + ai * 128 + m * 16; const float rs = row_rstd(SS, row, fq); float ssq = 0.f;
#pragma unroll
            for (int bj = 0; bj < 2; ++bj) { const size_t off = (size_t)row * DM + col0 + bj * 128;
#pragma unroll
                for (int n = 0; n < 2; ++n) { const v2u pw = *(const v2u*)(PLEF + (size_t)row * (2 * DM) + u.pn * 512 + (col0 - u.pn * 256) + bj * 128 + 4 * n); f4 o = acc[ai][bj][m][n];
                    o[0] = sigm(o[0] * rs) * bf_lo(pw.x); o[1] = sigm(o[1] * rs) * bf_hi(pw.x); o[2] = sigm(o[2] * rs) * bf_lo(pw.y); o[3] = sigm(o[3] * rs) * bf_hi(pw.y);
                    const v2u xw = *(const v2u*)(XB + off + 4 * n);
                    o[0] += bf_lo(xw.x); o[1] += bf_hi(xw.x); o[2] += bf_lo(xw.y); o[3] += bf_hi(xw.y);
                    ssq += (o[0] * o[0] + o[1] * o[1]) + (o[2] * o[2] + o[3] * o[3]); acc[ai][bj][m][n] = o; } }
            ssq += __shfl_xor(ssq, 16); ssq += __shfl_xor(ssq, 32);
            if (fq == 0) __hip_atomic_store((unsigned*)(SSF + ((size_t)u.pn * MTOT + row) * 4 + wc), __float_as_uint(ssq), __ATOMIC_RELAXED, __HIP_MEMORY_SCOPE_AGENT); }
        { const float rs = row_rstd(SS, rowx, fq); float ssq = 0.f; const size_t off = (size_t)rowx * DM + colx;
#pragma unroll
          for (int n = 0; n < 2; ++n) { const v2u pw = *(const v2u*)(PLEF + (size_t)rowx * (2 * DM) + u.pn * 512 + (colx - u.pn * 256) + 4 * n); f4 o = ex[n];
              o[0] = sigm(o[0] * rs) * bf_lo(pw.x); o[1] = sigm(o[1] * rs) * bf_hi(pw.x); o[2] = sigm(o[2] * rs) * bf_lo(pw.y); o[3] = sigm(o[3] * rs) * bf_hi(pw.y);
              const v2u xw = *(const v2u*)(XB + off + 4 * n);
              o[0] += bf_lo(xw.x); o[1] += bf_hi(xw.x); o[2] += bf_lo(xw.y); o[3] += bf_hi(xw.y);
              ssq += (o[0] * o[0] + o[1] * o[1]) + (o[2] * o[2] + o[3] * o[3]); ex[n] = o; }
          ssq += __shfl_xor(ssq, 16); ssq += __shfl_xor(ssq, 32);
          if (fq == 0) __hip_atomic_store((unsigned*)(SSFX + ((size_t)u.pn * NSAMPLE + (rowx - NPROMPT)) * 8 + wr * 4 + wc), __float_as_uint(ssq), __ATOMIC_RELAXED, __HIP_MEMORY_SCOPE_AGENT); }
        asm volatile("s_waitcnt vmcnt(0)" ::: "memory");
        unsigned* c = cnt + 64 * u.pm;
        if (fr == 0 && fq == 0) __hip_atomic_fetch_add(c, 1u, __ATOMIC_RELAXED, __HIP_MEMORY_SCOPE_AGENT);
        if (wr == 0 && wc == 0) { unsigned sp = 0;
            while ((unsigned)__builtin_amdgcn_readfirstlane((int)__hip_atomic_load(c, __ATOMIC_RELAXED, __HIP_MEMORY_SCOPE_AGENT)) < 64u && ++sp < (1u << 22)) __builtin_amdgcn_s_sleep(2);
            __builtin_amdgcn_fence(__ATOMIC_ACQUIRE, "agent");
            asm volatile("s_waitcnt vmcnt(0)" ::: "memory"); }
        asm volatile("" ::: "memory"); __builtin_amdgcn_s_barrier(); asm volatile("" ::: "memory");
#pragma unroll
        EPI_ROWS { const int row = row0 + ai * 128 + m * 16; const float rsf = row_rstd(SSF, row, fq);
#pragma unroll
            for (int bj = 0; bj < 2; ++bj) { const size_t off = (size_t)row * DM + col0 + bj * 128; const int c0 = col0 + bj * 128;
#pragma unroll
                for (int n = 0; n < 2; ++n) *(f4*)(XR + off + 4 * n) = acc[ai][bj][m][n] * rsf * *(const f4*)(lnf + c0 + 4 * n); } }
        { float sx = 0.f;
#pragma unroll
          for (int p = 0; p < 2; ++p) { const float* sp = SSFX + ((size_t)(2 * fq + p) * NSAMPLE + (rowx - NPROMPT)) * 8; const f4 a = *(const f4*)sp, b = *(const f4*)(sp + 4);
              sx += ((a[0] + a[1]) + (a[2] + a[3])) + ((b[0] + b[1]) + (b[2] + b[3])); }
          sx += __shfl_xor(sx, 16); sx += __shfl_xor(sx, 32);
          const float rsf = __builtin_amdgcn_rsqf(sx * (1.f / DM) + EPS);
#pragma unroll
          for (int n = 0; n < 2; ++n) *(f4*)(XR + (size_t)rowx * DM + colx + 4 * n) = ex[n] * rsf * *(const f4*)(lnf + colx + 4 * n); }
        return true;
    }
};
#undef EPI_ROWS
}

namespace scan {
typedef short v4i16_t __attribute__((ext_vector_type(4)));
__device__ __forceinline__ s16x4 vtr(const LAS unsigned char* p) { return __builtin_bit_cast(s16x4, __builtin_amdgcn_ds_read_tr16_b64_v4i16((LAS v4i16_t*)p)); }
__device__ __forceinline__ bf16x8 cat8(s16x4 lo, s16x4 hi) { return (bf16x8){lo[0], lo[1], lo[2], lo[3], hi[0], hi[1], hi[2], hi[3]}; }
template <int CTRL> __device__ __forceinline__ float dpp_mov(float v) { return __builtin_bit_cast(float, __builtin_amdgcn_update_dpp(0, __builtin_bit_cast(int, v), CTRL, 0xF, 0xF, true)); }
__device__ __forceinline__ float row16_sum(float v) { v += dpp_mov<0xB1>(v); v += dpp_mov<0x4E>(v); v += dpp_mov<0x141>(v); v += dpp_mov<0x140>(v); return v; }
typedef float f32x2_t __attribute__((ext_vector_type(2))); typedef __bf16 bf16x2_t __attribute__((ext_vector_type(2)));
__device__ __forceinline__ unsigned cvtpk(float lo, float hi) { f32x2_t v = {lo, hi}; bf16x2_t b = __builtin_convertvector(v, bf16x2_t); return __builtin_bit_cast(unsigned, b); }
__device__ __forceinline__ float logsig(float x) { return fminf(x, 0.f) - __logf(1.f + __expf(-fabsf(x))); }
struct Tensors { const bf16* Z; bf16* Zw; unsigned char* AD; float* LFS; const float* LOGF; const float* GLR; const float* wgk; const float* bgk; const float* hg_gain; const float* gla_gain; bf16* BR;
                 const float* st_h; const float* st_g; float* out; };
constexpr int AD_BYTES = 3072;
__device__ __forceinline__ void glds16(const void* gsrc, unsigned lds_dst) { unsigned keep;
    asm volatile("s_mov_b32 %0, m0\n\ts_mov_b32 m0, %2\n\ts_nop 0\n\tglobal_load_lds_dwordx4 %1, off\n\ts_mov_b32 m0, %0" : "=&s"(keep) : "v"(gsrc), "s"(lds_dst) : "memory"); }
__device__ __forceinline__ int fsw(int row) { return (2 * (row & 7)) ^ ((row >> 3) & 1); }
template <int KIND>
__device__ __forceinline__ void prepass_items(LAS unsigned char* lds, const Tensors& T, int bx, int G, int tid) {
    constexpr int RP = 288, TILE = 32 * RP, O_QE = 0, O_KE = TILE, NSEQ = KIND ? 16 : 32, SEQ0 = KIND ? 0 : 16, NH = KIND ? GLH : HGH;
    asm volatile("" : "+v"(tid));
    const int lane = tid & 63, wave = __builtin_amdgcn_readfirstlane(tid >> 6), l15 = lane & 15, g = lane >> 4, q4 = l15 >> 2, kc = 16 * wave + l15;
    const int wbase = 4 * g * RP + ((((kc >> 3) ^ (2 * g))) << 4) + (kc & 7) * 2;
    for (int it = bx; it < NSEQ * (SEQ / 32); it += G) {
        const int sq = it >> 6, n = it & 63, b = sq / NH, h = sq % NH;
        const int qcol = KIND ? ZC_GQ + h * 128 : ZC_HQ + h * 128, kcol = KIND ? ZC_GK + h * 128 : ZC_HK + h * 128;
        const size_t r0 = (size_t)(b * SEQ + n * 32);
        unsigned char* ad = T.AD + ((size_t)(SEQ0 + sq) * (SEQ / 32) + n) * AD_BYTES;
        float lf[8]; unsigned short qh[8], kh[8];
#pragma unroll
        for (int tt = 0; tt < 2; ++tt) {
            if (KIND) { const float* gp = T.GLR + (r0 + 16 * tt + l15) * 16 + 8 * (g & 1); const f32x4 g0 = *(const f32x4*)gp, g1 = *(const f32x4*)(gp + 4);
                float x[8] = {g0[0], g0[1], g0[2], g0[3], g1[0], g1[1], g1[2], g1[3]};
#pragma unroll
                for (int e = 0; e < 8; ++e) { const float hi = __uint_as_float(f2bf(x[e]) << 16); x[e] = g >= 2 ? x[e] - hi : hi; }
                v4u a; a.x = cvtpk(x[0], x[1]); a.y = cvtpk(x[2], x[3]); a.z = cvtpk(x[4], x[5]); a.w = cvtpk(x[6], x[7]);
                const float* wp = T.wgk + (size_t)(8 * (g & 1)) * 512 + h * 128 + kc; v4u w;
                w.x = cvtpk(wp[0], wp[512]); w.y = cvtpk(wp[1024], wp[1536]); w.z = cvtpk(wp[2048], wp[2560]); w.w = cvtpk(wp[3072], wp[3584]);
                const float bgv = T.bgk[h * 128 + kc];
                const f32x4 d = __builtin_amdgcn_mfma_f32_16x16x32_bf16(__builtin_bit_cast(bf16x8, a), __builtin_bit_cast(bf16x8, w), (f32x4){bgv, bgv, bgv, bgv}, 0, 0, 0);
#pragma unroll
                for (int r = 0; r < 4; ++r) lf[4 * tt + r] = logsig(d[r]) * (1.4426950408889634f / 16.f); }
#pragma unroll
            for (int r = 0; r < 4; ++r) { const size_t row = r0 + 16 * tt + 4 * g + r;
                if (!KIND) lf[4 * tt + r] = T.LOGF[row * 1024 + h * 128 + kc] * 1.4426950408889634f;
                qh[4 * tt + r] = T.Zw[row * LDZ + qcol + kc]; kh[4 * tt + r] = T.Zw[row * LDZ + kcol + kc]; } }
        lf[1] += lf[0]; lf[2] += lf[1]; lf[3] += lf[2]; lf[5] += lf[4]; lf[6] += lf[5]; lf[7] += lf[6];
        float s0[4], s1[4];
#pragma unroll
        for (int j = 0; j < 4; ++j) { s0[j] = __shfl(lf[3], l15 + 16 * j); s1[j] = __shfl(lf[7], l15 + 16 * j); }
        const float h0 = (s0[0] + s0[1]) + (s0[2] + s0[3]), last = h0 + ((s1[0] + s1[1]) + (s1[2] + s1[3]));
        const float pre = g == 0 ? 0.f : (g == 1 ? s0[0] : (g == 2 ? s0[0] + s0[1] : s0[0] + s0[1] + s0[2]));
        const float pre1 = h0 + (g == 0 ? 0.f : (g == 1 ? s1[0] : (g == 2 ? s1[0] + s1[1] : s1[0] + s1[1] + s1[2])));
        const float ref = h0 + __shfl(lf[4], l15);
        const float eref = __builtin_amdgcn_exp2f(ref), elr = __builtin_amdgcn_exp2f(last - ref);
#pragma unroll
        for (int e = 0; e < 8; ++e) { const float cum = lf[e] + (e < 4 ? pre : pre1), E = __builtin_amdgcn_exp2f(cum - ref), Ei = __builtin_amdgcn_exp2f(ref - cum);
            const float q = bf2f(qh[e]) * E, k = bf2f(kh[e]) * Ei; const int o = wbase + ((e >> 2) * 16 + (e & 3)) * RP;
            const unsigned a = cvtpk(q, q * eref), c = cvtpk(k, k * elr);
            *(LAS bf16*)(lds + O_QE + o) = (bf16)a; *(LAS bf16*)(lds + O_KE + o) = (bf16)c;
            const size_t row = r0 + (e >> 2) * 16 + 4 * g + (e & 3);
            T.Zw[row * LDZ + qcol + kc] = (bf16)(a >> 16); T.Zw[row * LDZ + kcol + kc] = (bf16)(c >> 16); }
        if (g == 0) *(float*)(ad + 2048 + kc * 4) = __builtin_amdgcn_exp2f(last);
        __syncthreads();
        if (wave < 3) { const int st = wave == 2 ? 1 : 0, tt = wave == 0 ? 0 : 1; f32x4 d = (f32x4){0.f, 0.f, 0.f, 0.f};
#pragma unroll
            for (int ks = 0; ks < 4; ++ks) { const int co = l15 * RP + ((((4 * ks + g) ^ (2 * q4))) << 4);
                d = __builtin_amdgcn_mfma_f32_16x16x32_bf16(*(const LAS bf16x8*)(lds + O_KE + 16 * st * RP + co), *(const LAS bf16x8*)(lds + O_QE + 16 * tt * RP + co), d, 0, 0, 0); }
            if (st == tt) {
#pragma unroll
                for (int r = 0; r < 4; ++r) d[r] = l15 >= 4 * g + r ? d[r] : 0.f; }
            *(v2u*)(ad + ((tt * 4 + g) * 16 + l15) * 16 + st * 8) = (v2u){cvtpk(d[0], d[1]), cvtpk(d[2], d[3])};
        } else if (wave == 3) *(v2u*)(ad + (g * 16 + l15) * 16 + 8) = (v2u){0u, 0u};
        __syncthreads();
    }
}

template <int NV>
__device__ __forceinline__ void prompt_scan(LAS unsigned char* lds, const Tensors& T, int b, int h, int tid) {
    constexpr int KIND = NV - 1, V = 128 * NV, NST = 3, NCH = SEQ / 32; constexpr bool GLDS = NV == 1;
    constexpr int O_QIN = 0, O_KOUT = 8192, O_V = 16384, O_G = 16384 + 8192 * NV, O_AD = O_G + (GLDS ? 8192 * NV : 0), STG = O_AD + AD_BYTES, O_RED = NST * STG, O_DUMMY = O_RED + 2048;
    constexpr int NPG = GLDS ? 8 * NV : 0, NP = 19 + 8 * NV + NPG, PPW = (NP + 7) / 8;
    static_assert(O_DUMMY + 1024 <= RING_BYTES, "scan LDS");
    asm volatile("" : "+v"(tid));
    const int lane = tid & 63, wave = __builtin_amdgcn_readfirstlane(tid >> 6), l15 = lane & 15, g = lane >> 4;
    const int qcol = KIND ? ZC_GQ + h * 128 : ZC_HQ + h * 128, kcol = KIND ? ZC_GK + h * 128 : ZC_HK + h * 128;
    const int vcol = KIND ? ZC_GV + h * 256 : ZC_HV + h * 128, gcol = KIND ? ZC_GG + h * 256 : ZC_HG + h * 128, ocol = KIND ? 1024 + h * 256 : h * 128;
    const float* gain = KIND ? T.gla_gain : T.hg_gain;
    const int vw = wave * 16 * NV;
    const unsigned char* adq = T.AD + ((size_t)((KIND ? 0 : 16) + b * (KIND ? GLH : HGH) + h) * NCH) * AD_BYTES;
    f32x4 S[NV][8];
#pragma unroll
    for (int nv = 0; nv < NV; ++nv)
#pragma unroll
        for (int kt = 0; kt < 8; ++kt) S[nv][kt] = (f32x4){0.f, 0.f, 0.f, 0.f};
    float gn[NV];
#pragma unroll
    for (int nv = 0; nv < NV; ++nv) gn[nv] = gain[vw + 16 * nv + l15];
    const unsigned lds0 = (unsigned)(uintptr_t)lds;
    const unsigned char* psrc[PPW]; int pdst[PPW]; unsigned pstr[PPW];
#pragma unroll
    for (int j_ = 0; j_ < PPW; ++j_) { const int i_ = wave + 8 * j_; const size_t r0_ = (size_t)(b * SEQ);
        if (i_ < 16) { const int p_ = i_ & 7, row_ = 4 * p_ + (lane >> 4), c_ = lane & 15;
            psrc[j_] = (const unsigned char*)(T.Z + (r0_ + row_) * LDZ + (i_ < 8 ? qcol : kcol) + ((c_ ^ fsw(row_)) << 3)); pdst[j_] = (i_ < 8 ? O_QIN : O_KOUT) + p_ * 1024; pstr[j_] = 32u * LDZ * 2u; }
        else if (i_ < 16 + 8 * NV + NPG) { const int gsel_ = i_ >= 16 + 8 * NV, p_ = i_ - 16 - (gsel_ ? 8 * NV : 0), row_ = NV == 1 ? 4 * p_ + (lane >> 4) : 2 * p_ + (lane >> 5), c_ = NV == 1 ? (lane & 15) : (lane & 31);
            psrc[j_] = (const unsigned char*)(T.Z + (r0_ + row_) * LDZ + (gsel_ ? gcol : vcol) + ((gsel_ ? c_ : (c_ ^ fsw(row_))) << 3)); pdst[j_] = (gsel_ ? O_G : O_V) + p_ * 1024; pstr[j_] = 32u * LDZ * 2u; }
        else if (i_ < NP) { const int p_ = i_ - 16 - 8 * NV - NPG; psrc[j_] = adq + p_ * 1024 + lane * 16; pdst[j_] = O_AD + p_ * 1024; pstr[j_] = AD_BYTES; }
        else { psrc[j_] = adq + 2048 + lane * 16; pdst[j_] = -1; pstr[j_] = AD_BYTES; } }
#define SCAN_DMA(m, st) do { const int m_ = (m); const bool live_ = m_ < NCH; const unsigned mm_ = live_ ? (unsigned)m_ : (unsigned)(NCH - 1); \
        _Pragma("unroll") for (int j_ = 0; j_ < PPW; ++j_) { const int dst_ = (live_ && pdst[j_] >= 0) ? (st) * STG + pdst[j_] : O_DUMMY; \
            glds16(psrc[j_] + (size_t)mm_ * pstr[j_], (unsigned)__builtin_amdgcn_readfirstlane((int)(lds0 + dst_))); } } while (0)
    SCAN_DMA(0, 0); SCAN_DMA(1, 1); asm volatile("s_waitcnt vmcnt(%0)" :: "n"(PPW) : "memory");
    __builtin_amdgcn_s_barrier(); asm volatile("" ::: "memory");
    int st = 0;
    for (int n = 0; n < NCH; ++n) {
        const size_t row0 = (size_t)(b * SEQ + n * 32);
        int l15_ = lane & 15; asm volatile("" : "+v"(l15_));
        const int q4 = l15_ >> 2, p4 = l15_ & 3;
        unsigned gtr[2][NV][4];
        if (!GLDS) {
#pragma unroll
            for (int tt = 0; tt < 2; ++tt)
#pragma unroll
                for (int nv = 0; nv < NV; ++nv)
#pragma unroll
                    for (int r = 0; r < 4; ++r) { const bf16* gp_ = T.Z + (row0 + 16 * tt + 4 * g + r) * LDZ + gcol + vw + 16 * nv + l15_;
                        asm volatile("global_load_ushort %0, %1, off" : "=v"(gtr[tt][nv][r]) : "v"(gp_) : "memory"); } }
        { const int stn = st + NST - 1 >= NST ? st - 1 : st + NST - 1; SCAN_DMA(n + NST - 1, stn); }
        const LAS unsigned char* sb = lds + st * STG;
        bf16x8 Bv[NV];
#pragma unroll
        for (int nv = 0; nv < NV; ++nv) { const int row = 4 * g + q4, ch = ((vw + 16 * nv) >> 3) + (p4 >> 1);
            const LAS unsigned char* vp = sb + O_V + row * (2 * V) + ((ch ^ fsw(row)) << 4) + (p4 & 1) * 8;
            Bv[nv] = cat8(vtr(vp), vtr(vp + 16 * (2 * V))); }
        f32x4 o[2][NV];
#pragma unroll
        for (int tt = 0; tt < 2; ++tt) { const bf16x8 A = *(const LAS bf16x8*)(sb + O_AD + ((tt * 4 + g) * 16 + l15_) * 16);
#pragma unroll
            for (int nv = 0; nv < NV; ++nv) o[tt][nv] = __builtin_amdgcn_mfma_f32_16x16x32_bf16(A, Bv[nv], (f32x4){0.f, 0.f, 0.f, 0.f}, 0, 0, 0); }
        bf16x8 Aq[2][4];
#pragma unroll
        for (int tt = 0; tt < 2; ++tt) { const int row = 16 * tt + l15_, f = fsw(row); const LAS unsigned char* qp = sb + O_QIN + row * 256 + (g & 1) * 8;
#pragma unroll
            for (int ks = 0; ks < 4; ++ks) Aq[tt][ks] = cat8(*(const LAS s16x4*)(qp + (((4 * ks + (g >> 1)) ^ f) << 4)), *(const LAS s16x4*)(qp + (((4 * ks + 2 + (g >> 1)) ^ f) << 4))); }
        bf16x8 Ak[8]; f32x4 d4[8];
        { const int row = 4 * g + q4; const LAS unsigned char* kb = sb + O_KOUT + row * 256 + (p4 & 1) * 8; const int fk = fsw(row);
#pragma unroll
          for (int kt = 0; kt < 8; ++kt) { const LAS unsigned char* kp = kb + (((2 * kt + (p4 >> 1)) ^ fk) << 4); Ak[kt] = cat8(vtr(kp), vtr(kp + 16 * 256)); d4[kt] = *(const LAS f32x4*)(sb + O_AD + 2048 + (16 * kt + 4 * g) * 4); } }
#pragma unroll
        for (int ks = 0; ks < 4; ++ks) { bf16x8 Bs[NV];
#pragma unroll
            for (int nv = 0; nv < NV; ++nv) { const f32x4 s0 = S[nv][2 * ks], s1 = S[nv][2 * ks + 1]; v4u w; w.x = cvtpk(s0[0], s0[1]); w.y = cvtpk(s0[2], s0[3]); w.z = cvtpk(s1[0], s1[1]); w.w = cvtpk(s1[2], s1[3]); Bs[nv] = __builtin_bit_cast(bf16x8, w); }
#pragma unroll
            for (int tt = 0; tt < 2; ++tt)
#pragma unroll
                for (int nv = 0; nv < NV; ++nv) o[tt][nv] = __builtin_amdgcn_mfma_f32_16x16x32_bf16(Aq[tt][ks], Bs[nv], o[tt][nv], 0, 0, 0); }
#pragma unroll
        for (int kt = 0; kt < 8; ++kt)
#pragma unroll
            for (int nv = 0; nv < NV; ++nv) S[nv][kt] = __builtin_amdgcn_mfma_f32_16x16x32_bf16(Ak[kt], Bv[nv], S[nv][kt] * d4[kt], 0, 0, 0);
        if (GLDS) {
#pragma unroll
        for (int tt = 0; tt < 2; ++tt)
#pragma unroll
            for (int nv = 0; nv < NV; ++nv)
#pragma unroll
                for (int r = 0; r < 4; ++r) gtr[tt][nv][r] = *(const LAS bf16*)(sb + O_G + ((16 * tt + 4 * g + r) * V + vw + 16 * nv + l15_) * 2); }
        LAS float* red = (LAS float*)(lds + O_RED + (n & 1) * 1024);
#pragma unroll
        for (int tt = 0; tt < 2; ++tt)
#pragma unroll
            for (int r = 0; r < 4; ++r) { float p = 0.f;
#pragma unroll
                for (int nv = 0; nv < NV; ++nv) p += o[tt][nv][r] * o[tt][nv][r];
                p = row16_sum(p);
                if (l15_ == 0) red[wave * 32 + 16 * tt + 4 * g + r] = p; }
        if (GLDS) { if (n == 0) asm volatile("s_waitcnt vmcnt(%0) lgkmcnt(0)" :: "n"(PPW) : "memory"); else asm volatile("s_waitcnt vmcnt(%0) lgkmcnt(0)" :: "n"(PPW + 8 * NV) : "memory"); }
        else { asm volatile("s_waitcnt vmcnt(%0) lgkmcnt(0)" :: "n"(PPW) : "memory");
#pragma unroll
            for (int tt = 0; tt < 2; ++tt)
#pragma unroll
                for (int nv = 0; nv < NV; ++nv) asm volatile("" : "+v"(gtr[tt][nv][0]), "+v"(gtr[tt][nv][1]), "+v"(gtr[tt][nv][2]), "+v"(gtr[tt][nv][3])); }
        __builtin_amdgcn_s_barrier(); asm volatile("" ::: "memory");
#pragma unroll
        for (int tt = 0; tt < 2; ++tt) { f32x4 ra = *(const LAS f32x4*)(red + (l15_ & 7) * 32 + 16 * tt + 4 * g);
#pragma unroll
            for (int r = 0; r < 4; ++r) { float x = ra[r]; x += dpp_mov<0xB1>(x); x += dpp_mov<0x4E>(x); x += dpp_mov<0x141>(x); ra[r] = x; }
#pragma unroll
            for (int r = 0; r < 4; ++r) { const int t = 16 * tt + 4 * g + r; const float rs = __builtin_amdgcn_rsqf(ra[r] * (1.f / V) + EPS);
#pragma unroll
                for (int nv = 0; nv < NV; ++nv) { const int vc = vw + 16 * nv + l15_;
                    const float y = o[tt][nv][r] * rs * gn[nv] * __uint_as_float(gtr[tt][nv][r] << 16); T.BR[(row0 + t) * DM + ocol + vc] = (bf16)cvtpk(y, y); } } }
        st = st + 1 == NST ? 0 : st + 1;
    }
#undef SCAN_DMA
    asm volatile("s_waitcnt vmcnt(0)" ::: "memory");
    float* so = T.out + (KIND ? OUT_GP + (size_t)(b * GLH + h) * 128 * V : OUT_HP + (size_t)(b * HGH + h) * 128 * V);
#pragma unroll
    for (int nv = 0; nv < NV; ++nv)
#pragma unroll
        for (int kt = 0; kt < 8; ++kt)
#pragma unroll
            for (int r = 0; r < 4; ++r) so[(size_t)(16 * kt + 4 * g + r) * V + vw + 16 * nv + l15] = S[nv][kt][r];
    __syncthreads();
}

constexpr int SS_QE = 0, SS_KE = 2048, SS_QIN = 4096, SS_KOUT = 6144, SS_DEC = 8192, SS_ATT = 8704, SS_WS = 8768  , SS_V = 9216  , SS_RED = 13312  ;
__device__ __forceinline__ void lds_barrier() { asm volatile("s_waitcnt lgkmcnt(0)" ::: "memory"); __builtin_amdgcn_s_barrier(); asm volatile("" ::: "memory"); }
template <int NV>
__device__ __forceinline__ void ss_load_small(const Tensors& T, int b, int h, int tid, unsigned short (&qh)[4], unsigned short (&kh)[4], float (&lf)[4], f32x4 (&gl)[4][4], float (&wk)[16], float& bgv,
                                              unsigned short (&vh)[NV], unsigned short (&gh)[NV], float (&gnv)[NV]) {
    constexpr int KIND = NV - 1, V = 128 * NV;
    const int qcol = KIND ? ZC_GQ + h * 128 : ZC_HQ + h * 128, kcol = KIND ? ZC_GK + h * 128 : ZC_HK + h * 128, vcol = KIND ? ZC_GV + h * 256 : ZC_HV + h * 128, gcol = KIND ? ZC_GG + h * 256 : ZC_HG + h * 128;
    const float* gain = KIND ? T.gla_gain : T.hg_gain; const int row0 = NPROMPT + b * DECS, k = tid & 127;
#pragma unroll
    for (int t = 0; t < 4; ++t) { const size_t row = (size_t)(row0 + t); qh[t] = T.Z[row * LDZ + qcol + k]; kh[t] = T.Z[row * LDZ + kcol + k];
        if (!KIND) lf[t] = T.LOGF[row * 1024 + h * 128 + k];
        else lf[t] = T.LFS[(size_t)(row - NPROMPT) * 512 + h * 128 + k]; }
    (void)gl; (void)wk; (void)bgv;
#pragma unroll
    for (int j = 0; j < NV; ++j) { const int i = tid + 512 * j, t = i / V, v = i % V; vh[j] = T.Z[(size_t)(row0 + t) * LDZ + vcol + v]; gh[j] = T.Z[(size_t)(row0 + t) * LDZ + gcol + v]; gnv[j] = gain[v]; }
}
template <int NV>
__device__ __forceinline__ int sample_scan(LAS unsigned char* lds, const Tensors& T, int b, int h, f32x4 (&sreg)[(128 * NV / 4) * 128 / 512], unsigned short (&qh)[4], unsigned short (&kh)[4], float (&lf)[4],
                                           f32x4 (&gl)[4][4], float (&wk)[16], float& bgv, unsigned short (&vh)[NV], unsigned short (&gh)[NV], float (&gnv)[NV], volatile LAS unsigned* nxt_word, int nitems, int tid) {
    constexpr int KIND = NV - 1, V = 128 * NV, V4 = V / 4, KR = 512 / V4, NR = 128 / KR, H = KIND ? GLH : HGH;
    asm volatile("" : "+v"(tid));
    const int lane = tid & 63, wave = __builtin_amdgcn_readfirstlane(tid >> 6);
    const int ocol = KIND ? 1024 + h * 256 : h * 128;
    const int row0 = NPROMPT + b * DECS;
    LAS float* qe = (LAS float*)(lds + SS_QE); LAS float* ke = (LAS float*)(lds + SS_KE); LAS float* qin = (LAS float*)(lds + SS_QIN); LAS float* kout = (LAS float*)(lds + SS_KOUT);
    LAS float* dec = (LAS float*)(lds + SS_DEC); LAS float* att = (LAS float*)(lds + SS_ATT); LAS float* wsum = (LAS float*)(lds + SS_WS); LAS float* vs = (LAS float*)(lds + SS_V); LAS float* red = (LAS float*)(lds + SS_RED);
    const int k = tid & 127;
    const int vq = tid % V4, kr = tid / V4;
    if (tid < 128) { float qv[4], kv[4];
#pragma unroll
        for (int t = 0; t < 4; ++t) { qv[t] = bf2f(qh[t]); kv[t] = bf2f(kh[t]); }
        lf[1] += lf[0]; lf[2] += lf[1]; lf[3] += lf[2];
#pragma unroll
        for (int t = 0; t < 4; ++t) { qe[t * 128 + k] = qv[t] * __expf(lf[t] - lf[2]); ke[t * 128 + k] = kv[t] * __expf(lf[2] - lf[t]); qin[t * 128 + k] = qv[t] * __expf(lf[t]); kout[t * 128 + k] = kv[t] * __expf(lf[3] - lf[t]); }
        dec[k] = __expf(lf[3]); }
#pragma unroll
    for (int j = 0; j < NV; ++j) vs[tid + 512 * j] = bf2f(vh[j]);
    lds_barrier();
    { const int pair = tid >> 5, t = pair >> 2, s = pair & 3, j = tid & 31; float a = 0.f;
#pragma unroll
      for (int i = 0; i < 4; ++i) a += qe[t * 128 + j + 32 * i] * ke[s * 128 + j + 32 * i];
      a += __shfl_xor(a, 16); a += __shfl_xor(a, 8); a += __shfl_xor(a, 4); a += __shfl_xor(a, 2); a += __shfl_xor(a, 1);
      if (j == 0) att[pair] = s <= t ? a : 0.f; }
    { float* sout = T.out + (KIND ? OUT_GS : OUT_HS) + (size_t)(b * H + h) * 128 * V;
      f32x4 vv[4], acc[4];
#pragma unroll
      for (int t = 0; t < 4; ++t) { vv[t] = *(const LAS f32x4*)(vs + t * V + 4 * vq); acc[t] = (f32x4){0.f, 0.f, 0.f, 0.f}; }
#pragma unroll
      for (int i = 0; i < NR; ++i) { const int k = kr + KR * i; const f32x4 s0 = sreg[i]; f32x4 sn = s0 * dec[k];
#pragma unroll
          for (int t = 0; t < 4; ++t) { acc[t] += s0 * qin[t * 128 + k]; sn += vv[t] * kout[t * 128 + k]; }
          *(f32x4*)(sout + (size_t)k * V + 4 * vq) = sn; }
#pragma unroll
      for (int t = 0; t < 4; ++t) *(LAS f32x4*)(red + (kr * 4 + t) * V + 4 * vq) = acc[t]; }
    const int nxt = (int)nxt_word[0];
    unsigned short gh2[NV]; float gnv2[NV];
#pragma unroll
    for (int j = 0; j < NV; ++j) { gh2[j] = gh[j]; gnv2[j] = gnv[j]; }
    if (nxt < nitems) { ss_load_small<NV>(T, nxt / H, nxt % H, tid, qh, kh, lf, gl, wk, bgv, vh, gh2, gnv2);
        const float* sn_ = (KIND ? T.st_g : T.st_h) + (size_t)nxt * 128 * V;
#pragma unroll
        for (int i = 0; i < NR; ++i) sreg[i] = *(const GAS f32x4*)(sn_ + (size_t)(kr + KR * i) * V + 4 * vq); }
    lds_barrier();
    float ov[NV];
#pragma unroll
    for (int j = 0; j < NV; ++j) { const int idx = tid + 512 * j, t = idx / V, v = idx % V; float o = 0.f;
#pragma unroll
        for (int kr = 0; kr < KR; ++kr) o += red[(kr * 4 + t) * V + v];
#pragma unroll
        for (int s = 0; s < 4; ++s) o += att[t * 4 + s] * vs[s * V + v];
        ov[j] = o; const float p = wave_sum(o * o); if (lane == 0) wsum[j * 8 + wave] = p; }
    lds_barrier();
#pragma unroll
    for (int j = 0; j < NV; ++j) { const int idx = tid + 512 * j, t = idx / V, v = idx % V; float tot = 0.f;
#pragma unroll
        for (int jj = 0; jj < NV; ++jj)
#pragma unroll
            for (int w = 0; w < 8; ++w) { const int tw = (w * 64 + 512 * jj) / V; tot += (tw == t) ? wsum[jj * 8 + w] : 0.f; }
        const float rs = __builtin_amdgcn_rsqf(tot * (1.f / V) + EPS); const size_t row = (size_t)(row0 + t);
        T.BR[row * DM + ocol + v] = (bf16)f2bf(ov[j] * rs * gnv[j] * bf2f(gh[j])); gh[j] = gh2[j]; gnv[j] = gnv2[j]; }
    lds_barrier();
    return nxt;
}
template <int NV>
__device__ __forceinline__ void sample_loop(LAS unsigned char* lds, const Tensors& T, volatile LAS unsigned* MISC, gu32* q, int tid) {
    constexpr int KIND = NV - 1, V = 128 * NV, V4 = V / 4, KR = 512 / V4, NR = 128 / KR, H = KIND ? GLH : HGH, NIT = DECB * H;
    if (tid == 0) MISC[16] = __hip_atomic_fetch_add(q, 1u, RLX_AGENT);
    __syncthreads();
    int cur = (int)MISC[16];
    __syncthreads();
    if (cur >= NIT) return;
    f32x4 sreg[NR]; unsigned short qh[4], kh[4], vh[NV], gh[NV]; float lf[4], wk[16], gnv[NV], bgv = 0.f; f32x4 gl[4][4];
    ss_load_small<NV>(T, cur / H, cur % H, tid, qh, kh, lf, gl, wk, bgv, vh, gh, gnv);
    { const int vq = tid % V4, kr = tid / V4; const float* sn_ = (KIND ? T.st_g : T.st_h) + (size_t)cur * 128 * V;
#pragma unroll
      for (int i = 0; i < NR; ++i) sreg[i] = *(const GAS f32x4*)(sn_ + (size_t)(kr + KR * i) * V + 4 * vq); }
    for (;;) {
        if (tid == 0) MISC[17] = __hip_atomic_fetch_add(q, 1u, RLX_AGENT);
        const int nxt = sample_scan<NV>(lds, T, cur / H, cur % H, sreg, qh, kh, lf, gl, wk, bgv, vh, gh, gnv, MISC + 17, NIT, tid);
        if (nxt >= NIT) break;
        cur = nxt;
    }
}
}

struct Args { const float* in[22]; float* out; unsigned char* ws; int ph_lo, ph_hi, li, pad; };
#ifndef MK_CUTS
#define MK_CUTS 0, 9
#endif
constexpr int N_PHASES = 8;
#ifndef SF_NUM
#define SF_NUM 9
#endif
constexpr int N_DEFER = 16 * (MTOT / 256);
enum { I_XP = 0, I_XS, I_STH, I_STG, I_PP, I_PS, I_HGLB, I_LN1, I_WIN, I_HGN, I_WGK, I_BGK, I_GLN, I_WBR, I_WOUT, I_LN2, I_WGU, I_WDN, I_LN3, I_WPLE, I_WPG, I_LNF };

__global__ void __launch_bounds__(NWAVES * 64, 2) mega_fwd(Args args) {
    extern __shared__ __attribute__((aligned(16))) unsigned char lds_raw[];
    LAS unsigned char* lds = (LAS unsigned char*)lds_raw;
    volatile LAS unsigned* MISC = (volatile LAS unsigned*)(lds + MISC_OFF);
    const int G = gridDim.x, bx = blockIdx.x;
#define FRESH_IDS int tid = threadIdx.x; asm volatile("" : "+v"(tid)); const int lane = tid & 63, wave = __builtin_amdgcn_readfirstlane(tid >> 6); (void)lane; (void)wave;
    unsigned char* ws = args.ws;
    gu32* ctl = (gu32*)(ws + WS_CTL);
    bf16* Win_t = (bf16*)(ws + WS_WIN); bf16* Wb_t = (bf16*)(ws + WS_WB); bf16* Wout_t = (bf16*)(ws + WS_WOUT); bf16* Wgu_t = (bf16*)(ws + WS_WGU);
    bf16* Wdn_t = (bf16*)(ws + WS_WDN); bf16* Wpg_t = (bf16*)(ws + WS_WPG); bf16* Wple_t = (bf16*)(ws + WS_WPLE);
    bf16* PB = (bf16*)(ws + WS_PB); float* RSTD1 = (float*)(ws + WS_RSTD1); float* GLR = (float*)(ws + WS_GLR);
    float* SS2 = (float*)(ws + WS_SS2); float* SS3 = (float*)(ws + WS_SS3); float* SSF = (float*)(ws + WS_SSF);
    bf16* BUFA = (bf16*)(ws + WS_BUFA); bf16* BUFB = (bf16*)(ws + WS_BUFB); float* LOGF = (float*)(ws + WS_LOGF);
    bf16* Z = (bf16*)(ws + WS_Z); bf16* ACT = (bf16*)(ws + WS_Z); bf16* PLEF = (bf16*)(args.out + OUT_Y);
    float* XR = args.out + OUT_Y;
    for (int u = threadIdx.x; u < (LDS_BYTES - LDSCTL_OFF) / 4; u += NWAVES * 64) ((LAS unsigned*)(lds + LDSCTL_OFF))[u] = 0u;
    __syncthreads();
    const int ph_lo = args.ph_lo, ph_hi = args.ph_hi; int nbar = 0;
#define IN(k) (ph_lo <= (k) && (k) < ph_hi)
    int my_xcc = (int)(xb_xcc_id() & 15u), xcc_fast = -1;
    if (threadIdx.x == 0) __hip_atomic_fetch_add(ctl + CW_XCC + 64 * my_xcc, 1u, RLX_AGENT);
#define XCC_DECIDE() do { volatile LAS int* xw_ = (volatile LAS int*)(lds + LDSCTL_OFF + 128); \
        if (threadIdx.x == 0) { int r_ = -1; if ((G % 8) == 0) { unsigned sp_ = 0; bool ok_ = false; \
                for (;;) { unsigned sum_ = 0; ok_ = true; for (int j_ = 0; j_ < 16; ++j_) { const unsigned c_ = __hip_atomic_load(ctl + CW_XCC + 64 * j_, RLX_AGENT); sum_ += c_; ok_ = ok_ && (c_ == (j_ < 8 ? (unsigned)(G / 8) : 0u)); } \
                    if (sum_ >= (unsigned)G || ++sp_ > (1u << 20)) break; __builtin_amdgcn_s_sleep(2); } \
                if (ok_) r_ = my_xcc; } \
            xw_[0] = r_; } \
        __syncthreads(); xcc_fast = __builtin_amdgcn_readfirstlane(xw_[0]); } while (0)
#define SEAM(k) do { if (IN(k) && IN((k) + 1)) { if (nbar == 0) XCC_DECIDE(); ++nbar; grid_barrier(ctl + CW_BAR + args.li * 4096, (unsigned)nbar, G, bx, xcc_fast); } } while (0)

    if (IN(0)) {
        FRESH_IDS
        const int gw = bx * NWAVES + wave, NGW = G * NWAVES; (void)gw; (void)NGW;
        {
            LAS unsigned* img = (LAS unsigned*)(lds + RING_OFF);
            int base = 0;
#define P0_MAT(Wp, ks, WTp, Kk, Nn, md) do { const P0Mat m_{Wp, ks, WTp, Kk, Nn, md, ((Kk) / 64) * (((Nn) + 255) / 256)}; \
                int t_ = bx - (base % G); if (t_ < 0) t_ += G;            \
                f32x4 va[8], vb[8]; \
                if (t_ < m_.tiles) p0_tile_load(m_, t_, va, tid); \
                for (; t_ < m_.tiles; t_ += G) { \
                    if (t_ + G < m_.tiles) p0_tile_load(m_, t_ + G, vb, tid); \
                    p0_tile_store(m_, t_, va, img, tid); \
                    _Pragma("unroll") for (int e = 0; e < 8; ++e) va[e] = vb[e]; } \
                base += m_.tiles; } while (0)
            P0_MAT(args.in[I_WIN], args.in[I_LN1], Win_t, DM, INCOLS, 1);
#undef P0_MAT
        }
        for (int i = bx * 512 + tid; i < (N1PAD - INCOLS) * DM / 8; i += G * 512) *(GAS v4u*)(Win_t + (size_t)INCOLS * DM + (size_t)i * 8) = (v4u){0u, 0u, 0u, 0u};
        for (int mb = bx; mb < MTOT / 32; mb += G) for (int m = mb * 32 + wave; m < mb * 32 + 32; m += NWAVES) {
            const float* xrow = m < NPROMPT ? args.in[I_XP] + (size_t)m * DM : args.in[I_XS] + (size_t)(m - NPROMPT) * DM;
            const GAS f32x4* xr = (const GAS f32x4*)xrow + lane; f32x4 v[8]; float s = 0.f;
#pragma unroll
            for (int j = 0; j < 8; ++j) { v[j] = xr[64 * j]; s += (v[j].x * v[j].x + v[j].y * v[j].y) + (v[j].z * v[j].z + v[j].w * v[j].w); }
            s = wave_sum(s);
            GAS v2u* o8 = (GAS v2u*)(BUFA + (size_t)m * DM) + lane;
#pragma unroll
            for (int j = 0; j < 8; ++j) o8[64 * j] = (v2u){pk2(v[j].x, v[j].y), pk2(v[j].z, v[j].w)};
            if (lane == 0) RSTD1[m] = __builtin_amdgcn_rsqf(s * (1.f / DM) + EPS);
            const float* prow = m < NPROMPT ? args.in[I_PP] + (size_t)m * PLE : args.in[I_PS] + (size_t)(m - NPROMPT) * PLE;
            const f32x4 pv = ((const GAS f32x4*)prow)[lane];
            ((GAS v2u*)(PB + (size_t)m * PLE))[lane] = (v2u){pk2(pv.x, pv.y), pk2(pv.z, pv.w)};
        }
    }
    SEAM(0);

    if (IN(1)) {
        pg8::Sched S{MTOT / 256, 29, (MTOT / 256) * 29, G, bx, 1, (const char*)BUFA, (const char*)Win_t, (size_t)256 * DM * 2, (size_t)256 * DM * 2, 0, 0, 28, 44};
        epi::Epi1 E{Z, LOGF, GLR, RSTD1, args.in[I_HGLB]};
        { const int r1 = (bx % 3) + 1;
          pg8::Sched Sa = S; Sa.icount = r1; pg8::gemm_phase(lds + RING_OFF, pg8::Gemm{DM, DM, DM / 64}, Sa, E);
          { FRESH_IDS
            LAS unsigned* img = (LAS unsigned*)(lds + RING_OFF);
            constexpr int T_GU = (DM / 64) * (2 * DFF / 256), T_DN = (DFF / 64) * (DM / 256), T_SQ = (DM / 64) * (DM / 256), T_BR = (1024 / 64) * (DM / 256), T_PL = (PLE / 64) * (DM / 256);
            constexpr int T_TOT = T_GU + T_DN + 2 * T_SQ + 2 * T_BR + T_PL;
#define P0_PICK(gid, m, lt) do { int r_ = (gid); \
                if (r_ < T_GU) { m = P0Mat{args.in[I_WGU], args.in[I_LN2], Wgu_t, DM, 2 * DFF, 2, T_GU}; lt = r_; } else { r_ -= T_GU; \
                if (r_ < T_DN) { m = P0Mat{args.in[I_WDN], nullptr, Wdn_t, DFF, DM, 0, T_DN}; lt = r_; } else { r_ -= T_DN; \
                if (r_ < T_SQ) { m = P0Mat{args.in[I_WOUT], nullptr, Wout_t, DM, DM, 0, T_SQ}; lt = r_; } else { r_ -= T_SQ; \
                if (r_ < T_SQ) { m = P0Mat{args.in[I_WPG], args.in[I_LN3], Wpg_t, DM, DM, 0, T_SQ}; lt = r_; } else { r_ -= T_SQ; \
                if (r_ < T_BR) { m = P0Mat{args.in[I_WBR], nullptr, Wb_t, 1024, DM, 0, T_BR}; lt = r_; } else { r_ -= T_BR; \
                if (r_ < T_BR) { m = P0Mat{args.in[I_WBR] + (size_t)1024 * DM, nullptr, Wb_t + (size_t)DM * 1024, 1024, DM, 0, T_BR}; lt = r_; } else { r_ -= T_BR; \
                m = P0Mat{args.in[I_WPLE], nullptr, Wple_t, PLE, DM, 0, T_PL}; lt = r_; } } } } } } } while (0)
            P0Mat ma{}, mb{}, mc{}; int la = 0, lb = 0, lc = 0; f32x4 va[8], vb[8], vc[8];
            if (bx < T_TOT) { P0_PICK(bx, ma, la); p0_tile_load(ma, la, va, tid); }
            if (bx + G < T_TOT) { P0_PICK(bx + G, mb, lb); p0_tile_load(mb, lb, vb, tid); }
            for (int gt = bx; gt < T_TOT; gt += G) {
                if (gt + 2 * G < T_TOT) { P0_PICK(gt + 2 * G, mc, lc); p0_tile_load(mc, lc, vc, tid); }
                p0_tile_store(ma, la, va, img, tid);
                ma = mb; la = lb; mb = mc; lb = lc;
#pragma unroll
                for (int e = 0; e < 8; ++e) { va[e] = vb[e]; vb[e] = vc[e]; } }
#undef P0_PICK
          }
          pg8::Sched Sb = S; Sb.i0 = r1; pg8::gemm_phase(lds + RING_OFF, pg8::Gemm{DM, DM, DM / 64}, Sb, E); }
        const int nfull = (MTOT / 256) * 29, rem = nfull % G, n_early = (G >= 96 && rem) ? G - rem : 0;
        if (n_early && bx >= rem) { pg8::SchedList SL{N_DEFER - n_early + (bx - rem), G, N_DEFER, MTOT / 256, 28, (const char*)BUFA, (const char*)Win_t, (size_t)256 * DM * 2, (size_t)256 * DM * 2};
            pg8::gemm_phase(lds + RING_OFF, pg8::Gemm{DM, DM, DM / 64}, SL, E); }
    }
    SEAM(1);

    if (IN(2)) {
        FRESH_IDS
        scan::Tensors T{Z, Z, ws + WS_AD, (float*)(ws + WS_AD + 10 * MiB), LOGF, GLR, args.in[I_WGK], args.in[I_BGK], args.in[I_HGN], args.in[I_GLN], BUFB, args.in[I_STH], args.in[I_STG], args.out};
        for (int i = bx * 512 + tid; i < NSAMPLE * 512; i += G * 512) { const int row = i >> 9, col = i & 511; float x = args.in[I_BGK][col];
            const float* gr = GLR + (size_t)(NPROMPT + row) * 16;
#pragma unroll
            for (int r = 0; r < 16; ++r) x += gr[r] * args.in[I_WGK][r * 512 + col];
            T.LFS[i] = scan::logsig(x) * (1.f / 16.f); }
        if (G >= 96) {
            gu32* cG = ctl + CW_PRE; gu32* cH = ctl + CW_PRE + 64;
            scan::prepass_items<1>(lds, T, bx, G, tid);
            const unsigned n_arr = xcc_fast >= 0 ? 8u : (unsigned)G;
            cnt_arrive_x(cG, ctl + CW_PSUB, xcc_fast, (unsigned)(G / 8));
            if (bx >= 16) scan::prepass_items<0>(lds, T, bx - 16, G - 16, tid);
            cnt_arrive_x(cH, ctl + CW_PSUB + 512, xcc_fast, (unsigned)(G / 8));
            if (bx < 16) { cnt_wait(cG, n_arr); scan::prompt_scan<2>(lds, T, bx >> 2, bx & 3, tid); }
            else if (bx < 48) { cnt_wait(cH, n_arr); scan::prompt_scan<1>(lds, T, (bx - 16) >> 3, (bx - 16) & 7, tid); }
            else { const int nfull = (MTOT / 256) * 29, rem = nfull % G, n_early = rem ? G - rem : 0, n_units = N_DEFER - n_early;
                const int idx = bx - 48, nb = (G - 48) / 16, blk = idx / 16, r16 = idx % 16, tail = (G - 48) - 16 * nb;
                const bool sf = blk < nb && r16 < SF_NUM;
                const int n_odd = nb * SF_NUM, n_even = (G - 48) - n_odd, hi = sf ? blk * SF_NUM + r16 : (blk < nb ? blk * (16 - SF_NUM) + (r16 - SF_NUM) : nb * (16 - SF_NUM) + r16);
                const int n_ev_units = 3 * n_even < n_units ? 3 * n_even : n_units; (void)tail;
                epi::Epi1 E{Z, LOGF, GLR, RSTD1, args.in[I_HGLB]};
                if (sf) {
                    cnt_wait(cH, n_arr);
                    scan::sample_loop<2>(lds, T, MISC, ctl + CW_Q, tid);
                    scan::sample_loop<1>(lds, T, MISC, ctl + CW_Q + 64, tid);
                    pg8::SchedList SL{n_ev_units + hi, n_odd, n_units, MTOT / 256, 28, (const char*)BUFA, (const char*)Win_t, (size_t)256 * DM * 2, (size_t)256 * DM * 2};
                    pg8::gemm_phase(lds + RING_OFF, pg8::Gemm{DM, DM, DM / 64}, SL, E);
                } else {
                    pg8::SchedList SL{hi, n_even, n_ev_units, MTOT / 256, 28, (const char*)BUFA, (const char*)Win_t, (size_t)256 * DM * 2, (size_t)256 * DM * 2};
                    pg8::gemm_phase(lds + RING_OFF, pg8::Gemm{DM, DM, DM / 64}, SL, E); } }
            if (bx >= 16) { const int j = bx >= 48 ? bx - 48 : (G - 48) + (bx - 16);
                pg8::SchedList SLP{j, G - 16, (NPROMPT / 256) * (DM / 256), NPROMPT / 256, 0, (const char*)PB, (const char*)Wple_t, (size_t)256 * PLE * 2, (size_t)256 * PLE * 2};
                epi::EpiPle E2{PLEF}; pg8::gemm_phase_t<true>(lds + RING_OFF, pg8::Gemm{PLE, PLE, PLE / 64}, SLP, E2); }
            if (bx >= 16) cnt_wait(cH, n_arr);
        } else {
            scan::prepass_items<1>(lds, T, bx, G, tid);
            scan::prepass_items<0>(lds, T, bx, G, tid);
            ++nbar; grid_barrier(ctl + CW_BAR + args.li * 4096, (unsigned)nbar, G, bx, xcc_fast);
            { pg8::SchedList SL{bx, G, 16 * (MTOT / 256), MTOT / 256, 28, (const char*)BUFA, (const char*)Win_t, (size_t)256 * DM * 2, (size_t)256 * DM * 2};
              epi::Epi1 E{Z, LOGF, GLR, RSTD1, args.in[I_HGLB]};
              pg8::gemm_phase(lds + RING_OFF, pg8::Gemm{DM, DM, DM / 64}, SL, E); }
            for (int sq = bx; sq < 48; sq += G) {
                if (sq < 16) scan::prompt_scan<2>(lds, T, sq >> 2, sq & 3, tid);
                else scan::prompt_scan<1>(lds, T, (sq - 16) >> 3, (sq - 16) & 7, tid);
            }
        }
        if (!(G >= 96 && bx < 16)) {
            scan::sample_loop<2>(lds, T, MISC, ctl + CW_Q, tid);
            scan::sample_loop<1>(lds, T, MISC, ctl + CW_Q + 64, tid); }
    }
    SEAM(2);

    const bool panel_ok = (G == 256);
    int my_pm = 0; { pg8::Sched S0{NPROMPT / 256, DM / 256, (NPROMPT / 256) * (DM / 256), G, bx, 1, nullptr, nullptr, 0, 0, 0, 0}; pg8::Unit u0; if (S0.next(0, u0)) my_pm = u0.pm; }
    const bool ple_first = false, ple_in_p2 = (G >= 96) && IN(2);
#define PLE_GEMM() do { pg8::Sched S2{NPROMPT / 256, DM / 256, (NPROMPT / 256) * (DM / 256), G, bx, 1, (const char*)PB, (const char*)Wple_t, (size_t)256 * PLE * 2, (size_t)256 * PLE * 2, 0, 0}; \
        epi::EpiPle E2{PLEF}; pg8::gemm_phase_t<true>(lds + RING_OFF, pg8::Gemm{PLE, PLE, PLE / 64}, S2, E2); } while (0)
    if (IN(3)) {
        if (ple_first) PLE_GEMM();
        pg8::Sched S{NPROMPT / 256, DM / 256, (NPROMPT / 256) * (DM / 256), G, bx, 2, (const char*)BUFB, (const char*)Wb_t, (size_t)256 * DM * 2, (size_t)256 * 1024 * 2, (size_t)1024 * 2, (size_t)DM * 1024 * 2};
        epi::Epi2 E{Z, BUFA};
        pg8::gemm_phase_t<true>(lds + RING_OFF, pg8::Gemm{DM, 1024, 1024 / 64}, S, E);
    }
    if (panel_ok) { if (IN(3) && IN(4)) panel_barrier(ctl + CW_PB3 + 64 * my_pm, 8u, false);       } else SEAM(3);

    if (IN(4)) {
        pg8::Sched S{NPROMPT / 256, DM / 256, (NPROMPT / 256) * (DM / 256), G, bx, 1, (const char*)BUFA, (const char*)Wout_t, (size_t)256 * DM * 2, (size_t)256 * DM * 2, 0, 0};
        epi::EpiRes<false> E{args.in[I_XP], args.in[I_XS], nullptr, BUFB, SS2, (LAS float*)(lds + XS_OFF)};
        pg8::gemm_phase_t<true>(lds + RING_OFF, pg8::Gemm{DM, DM, DM / 64}, S, E);
        if (!ple_first && !ple_in_p2) PLE_GEMM();
    }
#undef PLE_GEMM
    SEAM(4);

    if (IN(5)) {
        pg8::Sched S{MTOT / 256, 2 * DFF / 256, (MTOT / 256) * (2 * DFF / 256), G, bx, 1, (const char*)BUFB, (const char*)Wgu_t, (size_t)256 * DM * 2, (size_t)256 * DM * 2, 0, 0};
        epi::Epi4 E{SS2, ACT};
        pg8::gemm_phase(lds + RING_OFF, pg8::Gemm{DM, DM, DM / 64}, S, E);
    }
    SEAM(5);

    if (IN(6)) {
        pg8::Sched S{NPROMPT / 256, DM / 256, (NPROMPT / 256) * (DM / 256), G, bx, 1, (const char*)ACT, (const char*)Wdn_t, (size_t)256 * DFF * 2, (size_t)256 * DFF * 2, 0, 0};
        epi::EpiRes<true> E{nullptr, nullptr, BUFB, BUFA, SS3, (LAS float*)(lds + XS_OFF)};
        pg8::gemm_phase_t<true>(lds + RING_OFF, pg8::Gemm{DFF, DFF, DFF / 64}, S, E);
    }
    if (panel_ok) { if (IN(6) && IN(7)) panel_barrier(ctl + CW_PB6 + 64 * my_pm, 8u, false);       } else SEAM(6);

    if (IN(7)) {
        pg8::Sched S{NPROMPT / 256, DM / 256, (NPROMPT / 256) * (DM / 256), G, bx, 1, (const char*)BUFA, (const char*)Wpg_t, (size_t)256 * DM * 2, (size_t)256 * DM * 2, 0, 0};
        epi::Epi6 E{SS3, PLEF, BUFA, XR, SSF, (float*)(ws + WS_SSFX), args.in[I_LNF], (unsigned*)(ctl + CW_PAN)};
        pg8::gemm_phase_t<true>(lds + RING_OFF, pg8::Gemm{DM, DM, DM / 64}, S, E);
    }
}

extern "C" void kernel_launch(void* const* d_in, const int* in_sizes, int n_in, void* d_out, int out_size, void* d_ws, size_t ws_size, hipStream_t stream) {
    static int grid = 0;
    if (grid == 0) {
        if (n_in != 22 || (size_t)out_size != OUT_END || ws_size < WS_END) { fprintf(stderr, "kernel_launch: unexpected shapes (n_in %d, out %d, ws %zu): nothing launched\n", n_in, out_size, ws_size); grid = -1; return; }
        int dev = 0, cus = 0;
        if (hipGetDevice(&dev) != hipSuccess || hipDeviceGetAttribute(&cus, hipDeviceAttributeMultiprocessorCount, dev) != hipSuccess) { grid = -1; return; }
        if (hipFuncSetAttribute((const void*)mega_fwd, hipFuncAttributeMaxDynamicSharedMemorySize, LDS_BYTES) != hipSuccess) { fprintf(stderr, "kernel_launch: hipFuncSetAttribute failed\n"); grid = -1; return; }
        int per_cu = 0;
        if (hipOccupancyMaxActiveBlocksPerMultiprocessor(&per_cu, (const void*)mega_fwd, NWAVES * 64, LDS_BYTES) != hipSuccess || per_cu < 1) { fprintf(stderr, "kernel_launch: occupancy query reports %d workgroups per CU\n", per_cu); }
        (void)hipGetLastError();
        if (per_cu < 1) { grid = -1; return; }
        grid = cus;
    }
    if (grid < 0) return;
    (void)hipMemsetAsync((char*)d_ws + WS_CTL, 0, CTL_ZERO_BYTES, stream);
    Args a{};
    for (int i = 0; i < 22; ++i) a.in[i] = (const float*)d_in[i];
    a.out = (float*)d_out; a.ws = (unsigned char*)d_ws;
    static const int cuts[] = { MK_CUTS };
    constexpr int NL = (int)(sizeof(cuts) / sizeof(int)) - 1;
    for (int li = 0; li < NL; ++li) { a.ph_lo = cuts[li]; a.ph_hi = cuts[li + 1]; a.li = li; hipLaunchKernelGGL(mega_fwd, dim3(grid), dim3(NWAVES * 64), LDS_BYTES, stream, a); }
}
```

```cpp
#include <hip/hip_runtime.h>
#include <cstdio>
#include <cstdint>

namespace pg8 {
#define PG8_LAS __attribute__((address_space(3)))
typedef unsigned short bf16_t;
typedef short bf16x8 __attribute__((ext_vector_type(8)));
typedef float f32x4 __attribute__((ext_vector_type(4)));
typedef unsigned u32x4 __attribute__((ext_vector_type(4)));
constexpr int BM = 256, BK = 64, HALF = 128, HTB = HALF * BK * 2  , STAGE_BYTES = 8 * HTB, NXCD = 8, WGM = 8;

__host__ __device__ __forceinline__ int lds_byte(int r, int c) { const int st = (r >> 4) * 2 + (c >> 5), rr = r & 15, cc = c & 31, ob = rr * 64 + cc * 2; return st * 1024 + (ob ^ (((ob >> 9) & 1) << 5)); }
__host__ __device__ __forceinline__ void stage_rc(int b, int& R, int& C) { const int st = b / 1024, sb = b % 1024, swz = sb ^ (((sb >> 9) & 1) << 5); R = (st >> 1) * 16 + swz / 64; C = (st & 1) * 32 + (swz % 64) / 2; }
__host__ __device__ __forceinline__ int perm32(int rho) { const int n = rho >> 4, i = rho & 15; return 8 * (i >> 2) + 4 * n + (i & 3); }

struct Unit { int pm, pn, sub; };
struct Gemm { int lda, ldb, nt; };

struct Sched {
    int nM, nN, nwg, G, c, subs;
    const char* A; const char* B; size_t a_tile, b_tile, a_sub, b_sub;
    int remap_from = -1, remap_to = 0, i0 = 0, icount = 1 << 30;
    __device__ __forceinline__ bool next(int i, Unit& u) const {
        if (i >= icount) return false; i += i0;
        const int round = (subs == 2) ? (i >> 1) : i; u.sub = (subs == 2) ? (i & 1) : 0;
        const long L = (long)round * G + c; if (L >= nwg) return false;
        int wgid = (int)L; { const int q = nwg / NXCD, r = nwg % NXCD, xcd = wgid % NXCD, off = wgid / NXCD; wgid = (xcd < r ? xcd * (q + 1) : r * (q + 1) + (xcd - r) * q) + off; }
        const int nig = WGM * nN, gid = wgid / nig, fm = gid * WGM, gsz = (nM - fm) < WGM ? (nM - fm) : WGM;
        u.pm = fm + ((wgid % nig) % gsz); u.pn = (wgid % nig) / gsz; if (u.pn == remap_from) u.pn = remap_to; return true;
    }
    __device__ __forceinline__ void ptrs(const Unit& u, const char*& a, const char*& b) const { a = A + (size_t)u.pm * a_tile + (size_t)u.sub * a_sub; b = B + (size_t)u.pn * b_tile + (size_t)u.sub * b_sub; }
    __device__ __forceinline__ const char* xptr(const Unit& u) const { return A + (size_t)nM * a_tile + (size_t)u.pm * (a_tile >> 4) + (size_t)u.sub * a_sub; }
};
struct SchedList {
    int first, stride, total, nM, pn0;
    const char* A; const char* B; size_t a_tile, b_tile;
    __device__ __forceinline__ bool next(int i, Unit& u) const { const int id = first + stride * i; if (id >= total) return false; u.pm = id % nM; u.pn = pn0 + id / nM; u.sub = 0; return true; }
    __device__ __forceinline__ void ptrs(const Unit& u, const char*& a, const char*& b) const { a = A + (size_t)u.pm * a_tile; b = B + (size_t)u.pn * b_tile; }
    __device__ __forceinline__ const char* xptr(const Unit& u) const { return A + (size_t)nM * a_tile + (size_t)u.pm * (a_tile >> 4); }
};

typedef float f32x2_t __attribute__((ext_vector_type(2))); typedef __bf16 bf16x2_t __attribute__((ext_vector_type(2)));
__device__ __forceinline__ unsigned cvt_pk_bf16(float lo, float hi) { f32x2_t v = {lo, hi}; bf16x2_t b = __builtin_convertvector(v, bf16x2_t); return __builtin_bit_cast(unsigned, b); }
__device__ __forceinline__ float bf_lo(unsigned u) { return __uint_as_float(u << 16); }
__device__ __forceinline__ float bf_hi(unsigned u) { return __uint_as_float(u & 0xffff0000u); }

constexpr int XBUF_OFF = 131072 + 4096;
template <bool EX, class Epi, class SchedT>
__device__ __forceinline__ void gemm_phase_t(PG8_LAS unsigned char* lds, const Gemm g, const SchedT& S, const Epi& E) {
    int tid = threadIdx.x; asm volatile("" : "+v"(tid));
    const int wid = __builtin_amdgcn_readfirstlane(tid >> 6), lane = tid & 63, wr = wid >> 2, wc = wid & 3, fr = lane & 15, fq = lane >> 4;
    int nt = g.nt; asm volatile("" : "+s"(nt));
    unsigned voffA[2], voffB[2];
#pragma unroll
    for (int i = 0; i < 2; ++i) { int R, C; stage_rc(tid * 16 + i * 8192, R, C); const int Rb = (R & ~31) + perm32(R & 31);
        voffA[i] = (unsigned)(R * g.lda + C) * 2u; voffB[i] = (unsigned)(Rb * g.ldb + C) * 2u; }
    const size_t kstep = (size_t)(BK * 2);
    const size_t hstepA = (size_t)HALF * g.lda * 2, hstepB = (size_t)HALF * g.ldb * 2;
    const unsigned ldsw = (unsigned)wid * 1024u;
    const int aoff = lds_byte(wr * 64 + fr, fq * 8), boff = lds_byte(wc * 32 + fr, fq * 8);
    unsigned voffX = 0; const int xoff = XBUF_OFF + lds_byte(fr, fq * 8);
    if constexpr (EX) { int R, C; stage_rc(tid * 4, R, C); voffX = (unsigned)(R * g.lda + C) * 2u; }
#define PG8_STAGEX(b, gbase) do { if constexpr (EX) { const char* gb_ = (const char*)(gbase); asm volatile("" : "+s"(gb_)); __builtin_amdgcn_global_load_lds((const unsigned*)(gb_ + voffX), (PG8_LAS unsigned*)(lds + XBUF_OFF + (b) * 2048 + wid * 256), 4, 0, 0); } } while (0)
#define PG8_MMAX1(Bt) do { _Pragma("unroll") for (int n = 0; n < 2; ++n) _Pragma("unroll") for (int k = 0; k < 2; ++k) ex[n] = __builtin_amdgcn_mfma_f32_16x16x32_bf16(Bt[n][k], At[0][k], ex[n], 0, 0, 0); } while (0)
#define PG8_MMA2X(b) do { __builtin_amdgcn_s_setprio(1); \
        _Pragma("unroll") for (int n = 0; n < 2; ++n) _Pragma("unroll") for (int k = 0; k < 2; ++k) acc[1][1][0][n] = __builtin_amdgcn_mfma_f32_16x16x32_bf16(B1[n][k], At[0][k], acc[1][1][0][n], 0, 0, 0); \
        PG8_SCHED; At[0][0] = *(const PG8_LAS bf16x8*)(lds + xoff + (b) * 2048); At[0][1] = *(const PG8_LAS bf16x8*)(lds + xoff + (b) * 2048 + 1024); PG8_SCHED; \
        _Pragma("unroll") for (int m = 1; m < 4; ++m) _Pragma("unroll") for (int n = 0; n < 2; ++n) _Pragma("unroll") for (int k = 0; k < 2; ++k) acc[1][1][m][n] = __builtin_amdgcn_mfma_f32_16x16x32_bf16(B1[n][k], At[m][k], acc[1][1][m][n], 0, 0, 0); \
        PG8_SCHED; if (wr == 0) PG8_MMAX1(B0); else PG8_MMAX1(B1); __builtin_amdgcn_s_setprio(0); } while (0)
#define PG8_WAIT_VK do { if constexpr (EX) PG8_WAIT_V(9); else PG8_WAIT_V(8); } while (0)
#define PG8_SA(b, h) (((b) * 2 + (h)) * HTB)
#define PG8_SB(b, h) ((4 + (b) * 2 + (h)) * HTB)
#define PG8_STAGE(bufoff, gbase, voff) do { const char* gb_ = (const char*)(gbase); asm volatile("" : "+s"(gb_)); _Pragma("unroll") for (int _i = 0; _i < 2; ++_i) \
        __builtin_amdgcn_global_load_lds((const unsigned*)(gb_ + (voff)[_i]), (PG8_LAS unsigned*)(lds + (bufoff) + ldsw + _i * 8192), 16, 0, 0); } while (0)
#define PG8_LDA(dst, b, h) do { _Pragma("unroll") for (int m = 0; m < 4; ++m) _Pragma("unroll") for (int k = 0; k < 2; ++k) dst[m][k] = *(const PG8_LAS bf16x8*)(lds + PG8_SA(b, h) + aoff + m * 2048 + k * 1024); } while (0)
#define PG8_LDB(dst, b, h) do { _Pragma("unroll") for (int n = 0; n < 2; ++n) _Pragma("unroll") for (int k = 0; k < 2; ++k) dst[n][k] = *(const PG8_LAS bf16x8*)(lds + PG8_SB(b, h) + boff + n * 2048 + k * 1024); } while (0)
#define PG8_MMA(ai, bj, At, Bt) do { __builtin_amdgcn_s_setprio(1); _Pragma("unroll") for (int m = 0; m < 4; ++m) _Pragma("unroll") for (int n = 0; n < 2; ++n) _Pragma("unroll") for (int k = 0; k < 2; ++k) \
        acc[ai][bj][m][n] = __builtin_amdgcn_mfma_f32_16x16x32_bf16(Bt[n][k], At[m][k], acc[ai][bj][m][n], 0, 0, 0); __builtin_amdgcn_s_setprio(0); } while (0)
#define PG8_WAIT_V(n) asm volatile("s_waitcnt vmcnt(" #n ")" ::: "memory")
#define PG8_WAIT_L(n) asm volatile("s_waitcnt lgkmcnt(" #n ")" ::: "memory")
#define PG8_BAR __builtin_amdgcn_s_barrier()
#define PG8_SCHED __builtin_amdgcn_sched_barrier(0)
    Unit cur, nxt; int ui = 0;
    if (!S.next(0, cur)) return;
    f32x4 acc[2][2][4][2];
#pragma unroll
    for (int a = 0; a < 2; ++a)
#pragma unroll
        for (int b = 0; b < 2; ++b)
#pragma unroll
            for (int m = 0; m < 4; ++m)
#pragma unroll
                for (int n = 0; n < 2; ++n) acc[a][b][m][n] = (f32x4){0.f, 0.f, 0.f, 0.f};
    bf16x8 At[4][2], B0[2][2], B1[2][2];
    f32x4 ex[2] = {{0.f, 0.f, 0.f, 0.f}, {0.f, 0.f, 0.f, 0.f}};
    const char* cA; const char* cB; S.ptrs(cur, cA, cB);
    const char* cX = cA; if constexpr (EX) cX = S.xptr(cur);
    PG8_STAGE(PG8_SB(0, 0), cB, voffB); PG8_STAGE(PG8_SB(0, 1), cB + hstepB, voffB); PG8_STAGE(PG8_SA(0, 0), cA, voffA); PG8_STAGE(PG8_SA(0, 1), cA + hstepA, voffA); PG8_STAGEX(0, cX);
    if (wr == 1) PG8_BAR;
    if constexpr (EX) PG8_WAIT_V(3); else PG8_WAIT_V(2);
    PG8_BAR;
    PG8_STAGE(PG8_SB(1, 0), cB + kstep, voffB); PG8_STAGE(PG8_SA(1, 0), cA + kstep, voffA); PG8_STAGE(PG8_SB(1, 1), cB + hstepB + kstep, voffB);
    PG8_WAIT_V(6); PG8_BAR;
    for (;;) {
        const bool has_next = S.next(ui + 1, nxt);
        const char* nA = cA; const char* nB = cB; if (has_next) S.ptrs(nxt, nA, nB);
        const char* nX = cX; if constexpr (EX) { if (has_next) nX = S.xptr(nxt); }
        for (int t = 0; t < nt; t += 2) {
            const bool last = (t == nt - 2);
            const char* a1 = cA + (size_t)(t + 1) * kstep;
            const char* a2 = last ? nA : cA + (size_t)(t + 2) * kstep; const char* b2 = last ? nB : cB + (size_t)(t + 2) * kstep;
            const char* a3 = a2 + kstep; const char* b3 = b2 + kstep;
            const char* x1 = cX + (size_t)(t + 1) * kstep; const char* x2 = last ? nX : cX + (size_t)(t + 2) * kstep;
            PG8_LDB(B0, 0, 0); PG8_LDB(B1, 0, 1); PG8_SCHED; PG8_LDA(At, 0, 0); PG8_STAGE(PG8_SA(1, 1), a1 + hstepA, voffA); if (wr == 1) PG8_STAGEX(1, x1);
            PG8_WAIT_VK; PG8_WAIT_L(0); PG8_BAR; PG8_MMA(0, 0, At, B0); PG8_MMA(0, 1, At, B1); PG8_BAR; PG8_SCHED;
            PG8_LDA(At, 0, 1); PG8_STAGE(PG8_SB(0, 0), b2, voffB); PG8_STAGE(PG8_SB(0, 1), b2 + hstepB, voffB); PG8_STAGE(PG8_SA(0, 0), a2, voffA); if (wr == 0) PG8_STAGEX(1, x1);
            PG8_WAIT_VK; PG8_WAIT_L(0); PG8_BAR; PG8_MMA(1, 0, At, B0); if constexpr (EX) PG8_MMA2X(0); else PG8_MMA(1, 1, At, B1); PG8_BAR; PG8_SCHED;
            PG8_LDB(B0, 1, 0); PG8_LDB(B1, 1, 1); PG8_SCHED; PG8_LDA(At, 1, 0); PG8_STAGE(PG8_SA(0, 1), a2 + hstepA, voffA); if (wr == 1) PG8_STAGEX(0, x2);
            PG8_WAIT_VK; PG8_WAIT_L(0); PG8_BAR; PG8_MMA(0, 0, At, B0); PG8_MMA(0, 1, At, B1); PG8_BAR; PG8_SCHED;
            PG8_LDA(At, 1, 1); PG8_STAGE(PG8_SB(1, 0), b3, voffB); PG8_STAGE(PG8_SB(1, 1), b3 + hstepB, voffB); PG8_STAGE(PG8_SA(1, 0), a3, voffA); if (wr == 0) PG8_STAGEX(0, x2);
            PG8_WAIT_VK; PG8_WAIT_L(0); PG8_BAR; PG8_MMA(1, 0, At, B0); if constexpr (EX) PG8_MMA2X(1); else PG8_MMA(1, 1, At, B1); PG8_BAR; PG8_SCHED;
        }
        if (wr == 0) PG8_BAR;
        bool zero; int efr = fr, efq = fq; asm volatile("" : "+v"(efr), "+v"(efq));
        if constexpr (EX) zero = E(acc, ex, cur, wr, wc, efr, efq); else zero = E(acc, cur, wr, wc, efr, efq);
        if (!has_next) break;
        if (zero) {
#pragma unroll
        for (int a = 0; a < 2; ++a)
#pragma unroll
            for (int b = 0; b < 2; ++b)
#pragma unroll
                for (int m = 0; m < 4; ++m)
#pragma unroll
                    for (int n = 0; n < 2; ++n) acc[a][b][m][n] = (f32x4){0.f, 0.f, 0.f, 0.f};
            ex[0] = (f32x4){0.f, 0.f, 0.f, 0.f}; ex[1] = (f32x4){0.f, 0.f, 0.f, 0.f};
        }
        cur = nxt; cA = nA; cB = nB; cX = nX; ++ui;
        if (wr == 1) PG8_BAR;
    }
    PG8_WAIT_V(0);
    PG8_BAR;
#undef PG8_SA
#undef PG8_SB
#undef PG8_STAGE
#undef PG8_STAGEX
#undef PG8_MMAX1
#undef PG8_MMA2X
#undef PG8_WAIT_VK
#undef PG8_LDA
#undef PG8_LDB
#undef PG8_MMA
#undef PG8_WAIT_V
#undef PG8_WAIT_L
#undef PG8_BAR
#undef PG8_SCHED
}
template <class Epi, class SchedT>
__device__ __forceinline__ void gemm_phase(PG8_LAS unsigned char* lds, const Gemm g, const SchedT& S, const Epi& E) { gemm_phase_t<false>(lds, g, S, E); }
}

constexpr int NWAVES = 8;
constexpr int DM = 2048, NPROMPT = 8192, NSAMPLE = 512, MTOT = NPROMPT + NSAMPLE;
constexpr int SEQ = 2048, DECB = 128, DECS = 4, PLE = 256, DFF = 5632;
constexpr int HGH = 8, GLH = 4;
constexpr int INCOLS = 11280, LDZ = 11264, N1PAD = 11520;
constexpr int ZC_HQ = 0, ZC_HK = 1024, ZC_HV = 2048, ZC_HG = 3072, ZC_GQ = 4096, ZC_GK = 4608, ZC_GV = 5120, ZC_GG = 6144, ZC_MG = 7168;
constexpr float EPS = 1e-6f, SQK = 0.08838834764831845f;

constexpr size_t MiB = 1u << 20;
constexpr size_t WS_CTL = 0, CTL_ZERO_BYTES = 256 * 1024;
constexpr size_t WS_WIN = 2 * MiB, WS_WB = 47 * MiB, WS_WOUT = 55 * MiB, WS_WGU = 63 * MiB, WS_WDN = 107 * MiB, WS_WPG = 129 * MiB, WS_WPLE = 137 * MiB;
constexpr size_t WS_PB = 138 * MiB;
constexpr size_t WS_RSTD1 = 143 * MiB, WS_GLR = WS_RSTD1 + 64 * 1024, WS_SS2 = 144 * MiB, WS_SS3 = WS_SS2 + 1280 * 1024, WS_SSF = WS_SS3 + 1280 * 1024;
constexpr size_t WS_SSFX = WS_SSF + 1152 * 1024;
constexpr size_t WS_BUFA = 148 * MiB, WS_BUFB = 182 * MiB;
constexpr size_t WS_LOGF = 216 * MiB;
constexpr size_t WS_Z = 250 * MiB;
constexpr size_t WS_PLEF = WS_LOGF;
constexpr size_t WS_AD = 437 * MiB;
constexpr size_t WS_END = 447 * MiB;
static_assert(WS_WIN + (size_t)N1PAD * DM * 2 <= WS_WB && WS_WGU + (size_t)2 * DFF * DM * 2 <= WS_WDN && WS_WDN + (size_t)DM * DFF * 2 <= WS_WPG && WS_PB + (size_t)MTOT * PLE * 2 <= WS_RSTD1, "ws map 1");
static_assert(WS_GLR + (size_t)MTOT * 16 * 4 <= WS_SS2 && WS_SSF + (size_t)MTOT * 32 * 4 <= WS_SSFX && WS_SSFX + (size_t)8 * NSAMPLE * 8 * 4 <= WS_BUFA && WS_BUFA + (size_t)MTOT * DM * 2 <= WS_BUFB && WS_BUFB + (size_t)MTOT * DM * 2 <= WS_LOGF, "ws map 2");
static_assert(WS_LOGF + (size_t)MTOT * 1024 * 4 <= WS_Z && WS_Z + (size_t)MTOT * LDZ * 2 <= WS_END && (size_t)MTOT * DFF * 2 <= 96 * MiB && WS_PLEF + (size_t)MTOT * DM * 2 <= WS_Z, "ws map 3");
constexpr size_t OUT_Y = 0, OUT_HP = (size_t)MTOT * DM, OUT_GP = OUT_HP + 4 * 8 * 128 * 128, OUT_HS = OUT_GP + 4 * 4 * 128 * 256, OUT_GS = OUT_HS + (size_t)128 * 8 * 128 * 128, OUT_END = OUT_GS + (size_t)128 * 4 * 128 * 256;
constexpr int CW_PSUB = 2048;
constexpr int CW_XCC = 1024;
constexpr int CW_PRE = 512;
constexpr int CW_Q = 64;
constexpr int CW_BAR = 4096;
constexpr int CW_PB3 = 12288, CW_PB6 = 16384;
constexpr int CW_PAN = 8192;

constexpr int RING_OFF = 0, RING_BYTES = 131072;
constexpr int LDSCTL_OFF = RING_BYTES, MISC_OFF = LDSCTL_OFF + 320;
constexpr int XS_OFF = pg8::XBUF_OFF + 4096;
constexpr int LDS_BYTES = 147456;

#define GAS __attribute__((address_space(1)))
#define LAS __attribute__((address_space(3)))
typedef unsigned short bf16;
typedef unsigned v4u __attribute__((ext_vector_type(4)));
typedef unsigned v2u __attribute__((ext_vector_type(2)));
typedef float f32x4 __attribute__((ext_vector_type(4)));
typedef short bf16x8 __attribute__((ext_vector_type(8)));
typedef short s16x4 __attribute__((ext_vector_type(4)));
typedef GAS unsigned gu32;
#define RLX_AGENT __ATOMIC_RELAXED, __HIP_MEMORY_SCOPE_AGENT
#define LDS_WAIT() asm volatile("s_waitcnt lgkmcnt(0)" ::: "memory")
#define VM_WAIT() asm volatile("s_waitcnt vmcnt(0)" ::: "memory")
__device__ __forceinline__ unsigned f2bf(float f) { unsigned u = __builtin_bit_cast(unsigned, f); return (u + 0x7fffu + ((u >> 16) & 1u)) >> 16; }
__device__ __forceinline__ unsigned pk2(float lo, float hi) { return f2bf(lo) | (f2bf(hi) << 16); }
__device__ __forceinline__ float bf2f(bf16 b) { return __uint_as_float((unsigned)b << 16); }
__device__ __forceinline__ float sigm(float v) { return __builtin_amdgcn_rcpf(1.f + __expf(-v)); }

#define XB_TMO      128
#define XB_XCNT(j)  (256  + 64 * (j))
#define XB_XSUB(j)  (1280 + 64 * (j))
#define XB_XGEN(j)  (2304 + 64 * (j))
#define XB_TOP      3328
#define XB_TOPGEN   3392
#define XCD_BAR_WORDS 3456
#define XB_SPIN_CAP (1u << 18)
__device__ __forceinline__ unsigned xb_ld(unsigned* p)              { return __hip_atomic_load(p, __ATOMIC_RELAXED, __HIP_MEMORY_SCOPE_AGENT); }
__device__ __forceinline__ unsigned xb_add(unsigned* p, unsigned v) { return __hip_atomic_fetch_add(p, v, __ATOMIC_RELAXED, __HIP_MEMORY_SCOPE_AGENT); }
__device__ __forceinline__ unsigned xb_xcc_id() { return (unsigned)__builtin_amdgcn_s_getreg((3 << 11) | 20) & 0xFu; }
#define XB_SPIN(cond, bar) do { unsigned _sp = 0; while (cond) { __builtin_amdgcn_s_sleep(1); \
    if ((++_sp & 255u) == 0u) { if (xb_ld(&(bar)[XB_TMO])) break; if (_sp > XB_SPIN_CAP) { atomicAdd(&(bar)[XB_TMO], 1u); break; } } } } while (0)
struct XcdBarrier { unsigned* bar; unsigned x; volatile LAS unsigned* st; };
__device__ __forceinline__ XcdBarrier xcd_barrier_post(unsigned* bar, volatile LAS unsigned* st) {
    XcdBarrier b; b.bar = bar; b.x = xb_xcc_id(); b.st = st;
    if (threadIdx.x == 0) (void)xb_add(&bar[XB_XCNT(b.x)], 1u);
    return b;
}
__device__ __forceinline__ void xcd_barrier_complete(unsigned* bar, unsigned x, unsigned& nloc, unsigned& nx) {
    const unsigned G = gridDim.x * gridDim.y * gridDim.z;
    unsigned sum, cnt, mine, sp = 0u;
    for (;;) {
        sum = 0u; cnt = 0u; mine = 0u;
#pragma unroll
        for (unsigned j = 0; j < 16; ++j) { const unsigned c = xb_ld(&bar[XB_XCNT(j)]); sum += c; cnt += (c > 0u) ? 1u : 0u; mine = (j == x) ? c : mine; }
        if (sum == G) break;
        __builtin_amdgcn_s_sleep(1);
        if ((++sp & 255u) == 0u) { if (xb_ld(&bar[XB_TMO])) break; if (sp > XB_SPIN_CAP) { atomicAdd(&bar[XB_TMO], 1u); break; } }
    }
    nloc = mine > 0u ? mine : 1u; nx = cnt > 0u ? cnt : 1u;
}
__device__ __forceinline__ void xcd_barrier(const XcdBarrier& b) {
    asm volatile("s_waitcnt vmcnt(0)" ::: "memory");
    __syncthreads();
    if (threadIdx.x == 0) {
        unsigned* bar = b.bar;
        __builtin_amdgcn_s_waitcnt(0);
        unsigned nloc = b.st[0], nx = b.st[1];
        if (nloc == 0u) { xcd_barrier_complete(bar, b.x, nloc, nx); b.st[0] = nloc; b.st[1] = nx; }
        const unsigned old = xb_add(&bar[XB_XSUB(b.x)], 1u);
        const unsigned gen = old / nloc;
        if (old + 1u == (gen + 1u) * nloc) {
            __builtin_amdgcn_fence(__ATOMIC_RELEASE, "agent");
            asm volatile("s_waitcnt vmcnt(0)" ::: "memory");
            const unsigned og = xb_add(&bar[XB_TOP], 1u);
            const unsigned tg = og / nx;
            if (og + 1u == (tg + 1u) * nx) xb_add(&bar[XB_TOPGEN], 1u);
            else XB_SPIN(xb_ld(&bar[XB_TOPGEN]) == tg, bar);
            __builtin_amdgcn_fence(__ATOMIC_ACQUIRE, "agent");
            xb_add(&bar[XB_XGEN(b.x)], 1u);
            asm volatile("s_waitcnt vmcnt(0)" ::: "memory");
        } else {
            XB_SPIN(xb_ld(&bar[XB_XGEN(b.x)]) == gen, bar);
            __builtin_amdgcn_fence(__ATOMIC_ACQUIRE, "agent");
            asm volatile("s_waitcnt vmcnt(0)" ::: "memory");
        }
    }
    __syncthreads();
}

__device__ __forceinline__ void grid_barrier(gu32* w, unsigned epoch, int G, int bx, int xcc = -1, bool release = true) {
    asm volatile("s_waitcnt vmcnt(0)" ::: "memory");
    __syncthreads();
    if (threadIdx.x == 0) {
        if (xcc < 0 && release) { __builtin_amdgcn_fence(__ATOMIC_RELEASE, "agent"); asm volatile("s_waitcnt vmcnt(0)" ::: "memory"); }
        const bool two = (G % 8) == 0; const int g = two ? (xcc >= 0 ? xcc : (bx & 7)) : 0; const unsigned nloc = two ? (unsigned)(G / 8) : (unsigned)G, ngrp = two ? 8u : 1u;
        gu32* sub = w + 64 * g; gu32* gen = w + 64 * (8 + g); gu32* top = w + 64 * 16; gu32* topgen = w + 64 * 17;
        unsigned sp = 0;
        if (__hip_atomic_fetch_add(sub, 1u, RLX_AGENT) + 1u == epoch * nloc) {
            if (xcc >= 0 && release) { __builtin_amdgcn_fence(__ATOMIC_RELEASE, "agent"); asm volatile("s_waitcnt vmcnt(0)" ::: "memory"); }
            if (__hip_atomic_fetch_add(top, 1u, RLX_AGENT) + 1u == epoch * ngrp) __hip_atomic_fetch_add(topgen, 1u, RLX_AGENT);
            else while (__hip_atomic_load(topgen, RLX_AGENT) < epoch && ++sp < (1u << 24)) __builtin_amdgcn_s_sleep(2);
            __hip_atomic_fetch_add(gen, 1u, RLX_AGENT);
        } else while (__hip_atomic_load(gen, RLX_AGENT) < epoch && ++sp < (1u << 24)) __builtin_amdgcn_s_sleep(4);
        __builtin_amdgcn_fence(__ATOMIC_ACQUIRE, "agent");
        asm volatile("s_waitcnt vmcnt(0)" ::: "memory");
    }
    __syncthreads();
}

__device__ __forceinline__ void panel_barrier(gu32* c, unsigned n, bool release = true) {
    asm volatile("s_waitcnt vmcnt(0)" ::: "memory");
    __syncthreads();
    if (threadIdx.x == 0) {
        if (release) { __builtin_amdgcn_fence(__ATOMIC_RELEASE, "agent"); asm volatile("s_waitcnt vmcnt(0)" ::: "memory"); }
        unsigned sp = 0;
        if (__hip_atomic_fetch_add(c, 1u, RLX_AGENT) + 1u < n) while (__hip_atomic_load(c, RLX_AGENT) < n && ++sp < (1u << 24)) __builtin_amdgcn_s_sleep(2);
        __builtin_amdgcn_fence(__ATOMIC_ACQUIRE, "agent");
        asm volatile("s_waitcnt vmcnt(0)" ::: "memory");
    }
    __syncthreads();
}

__device__ __forceinline__ void cnt_arrive(gu32* c) {
    asm volatile("s_waitcnt vmcnt(0)" ::: "memory");
    __syncthreads();
    if (threadIdx.x == 0) { __builtin_amdgcn_fence(__ATOMIC_RELEASE, "agent"); asm volatile("s_waitcnt vmcnt(0)" ::: "memory"); __hip_atomic_fetch_add(c, 1u, RLX_AGENT); }
}
__device__ __forceinline__ void cnt_arrive_x(gu32* c, gu32* sub, int xcc, unsigned nloc) {
    if (xcc < 0) { cnt_arrive(c); return; }
    asm volatile("s_waitcnt vmcnt(0)" ::: "memory");
    __syncthreads();
    if (threadIdx.x == 0 && __hip_atomic_fetch_add(sub + 64 * xcc, 1u, RLX_AGENT) + 1u == nloc) {
        __builtin_amdgcn_fence(__ATOMIC_RELEASE, "agent"); asm volatile("s_waitcnt vmcnt(0)" ::: "memory"); __hip_atomic_fetch_add(c, 1u, RLX_AGENT); }
}
__device__ __forceinline__ void cnt_wait(gu32* c, unsigned n) {
    if (threadIdx.x == 0) { unsigned sp = 0;
        while (__hip_atomic_load(c, RLX_AGENT) < n && ++sp < (1u << 24)) __builtin_amdgcn_s_sleep(2);
        __builtin_amdgcn_fence(__ATOMIC_ACQUIRE, "agent"); asm volatile("s_waitcnt vmcnt(0)" ::: "memory"); }
    __syncthreads();
}

__device__ __forceinline__ float wave_sum(float v) {
#pragma unroll
    for (int o = 1; o < 64; o <<= 1) v += __shfl_xor(v, o);
    return v;
}
template <int MODE> __device__ __forceinline__ int dest_row(int n) {
    if (MODE == 1) return n < 7168 ? n : (n < 7184 ? n + 4096 : n - 16);
    if (MODE == 2) { const int up = n >= DFF ? 1 : 0, j = n - up * DFF; return 256 * (j >> 7) + 128 * up + (j & 127); }
    return n;
}
template <int MODE> __device__ __forceinline__ void p0_transpose_item(const float* W, int K, int N, const float* kscale, bf16* WT, LAS float* scr, int item, int lane) {
    const int nblk = (N + 31) / 32, kb = item / nblk, nb = item % nblk, k0 = 64 * kb, n0 = 32 * nb;
    const int nl = n0 + (lane & 31); const bool nok = nl < N;
#pragma unroll 8
    for (int i = 0; i < 32; ++i) { const int kk = 2 * i + (lane >> 5); float v = nok ? W[(size_t)(k0 + kk) * N + nl] : 0.f; if (kscale) v *= kscale[k0 + kk]; scr[kk * 33 + (lane & 31)] = v; }
    LDS_WAIT(); asm volatile("" ::: "memory");
    const int c = lane & 7;
#pragma unroll
    for (int j = 0; j < 4; ++j) { const int n = (lane >> 3) + 8 * j; const LAS float* s = scr + (8 * c) * 33 + n;
        v4u o; o.x = pk2(s[0 * 33], s[1 * 33]); o.y = pk2(s[2 * 33], s[3 * 33]); o.z = pk2(s[4 * 33], s[5 * 33]); o.w = pk2(s[6 * 33], s[7 * 33]);
        if (n0 + n < N) *(GAS v4u*)(WT + (size_t)dest_row<MODE>(n0 + n) * K + k0 + 8 * c) = o; }
    LDS_WAIT(); asm volatile("" ::: "memory");
}

struct P0Mat { const float* W; const float* kscale; bf16* WT; int K, N, mode, tiles; };
__device__ __forceinline__ int dest_row_rt(int mode, int n) { return mode == 1 ? dest_row<1>(n) : (mode == 2 ? dest_row<2>(n) : n); }
__device__ __forceinline__ void p0_tile_load(const P0Mat& m, int tile, f32x4 (&v)[8], int tid) {
    const int ntn = (m.N + 255) >> 8, kb = tile / ntn, nb = tile - kb * ntn, k0 = 64 * kb, n0 = 256 * nb;
#pragma unroll
    for (int i = 0; i < 4; ++i) { const int idx = tid + 512 * i, rp = idx >> 6, n = n0 + 4 * (idx & 63); const float* p = m.W + (size_t)(k0 + 2 * rp) * m.N + n;
        if (n < m.N) { v[2 * i] = *(const GAS f32x4*)p; v[2 * i + 1] = *(const GAS f32x4*)(p + m.N); } else { v[2 * i] = (f32x4){0.f, 0.f, 0.f, 0.f}; v[2 * i + 1] = v[2 * i]; } }
}
__device__ __forceinline__ void p0_tile_store(const P0Mat& m, int tile, const f32x4 (&v)[8], LAS unsigned* img, int tid) {
    const int ntn = (m.N + 255) >> 8, kb = tile / ntn, nb = tile - kb * ntn, k0 = 64 * kb, n0 = 256 * nb;
#pragma unroll
    for (int i = 0; i < 4; ++i) { const int idx = tid + 512 * i, rp = idx >> 6, c4 = idx & 63;
        const float s0 = m.kscale ? m.kscale[k0 + 2 * rp] : 1.f, s1 = m.kscale ? m.kscale[k0 + 2 * rp + 1] : 1.f;
#pragma unroll
        for (int j = 0; j < 4; ++j) img[(4 * c4 + j) * 33 + rp] = pg8::cvt_pk_bf16(v[2 * i][j] * s0, v[2 * i + 1][j] * s1); }
    __syncthreads();
#pragma unroll
    for (int i = 0; i < 4; ++i) { const int idx = tid + 512 * i, n = idx >> 3, c = idx & 7; const LAS unsigned* q = img + n * 33 + 4 * c;
        const v4u o = (v4u){q[0], q[1], q[2], q[3]};
        if (n0 + n < m.N) *(GAS v4u*)(m.WT + (size_t)dest_row_rt(m.mode, n0 + n) * m.K + k0 + 8 * c) = o; }
    __syncthreads();
}

namespace epi {
using pg8::Unit; using pg8::cvt_pk_bf16; using pg8::bf_lo; using pg8::bf_hi;
typedef pg8::f32x4 f4; typedef pg8::u32x4 u4;
#define EPI_ROWS for (int ai = 0; ai < 2; ++ai) _Pragma("unroll") for (int m = 0; m < 4; ++m)
template <int T> __device__ __forceinline__ float act1(float v) {
    if (T == 2) return v;
    if (T == 4) return v * SQK;
    const float s = sigm(v);
    if (T == 0) return v * s * SQK;
    if (T == 3) return v * s;
    return s;
}
__device__ __forceinline__ __amdgpu_buffer_rsrc_t wt_rsrc(const void* base, size_t bytes) { return __builtin_amdgcn_make_buffer_rsrc((void*)base, (short)0, (int)bytes, 0x00020000); }
__device__ __forceinline__ void wt_store16(const __amdgpu_buffer_rsrc_t r, size_t elem_off_bf16, const u4& v) { __builtin_amdgcn_raw_buffer_store_b128(v, r, (unsigned)(elem_off_bf16 * 2), 0,   16); }
__device__ __forceinline__ u4 pack8(const f4& a, const f4& b) { u4 w; w.x = cvt_pk_bf16(a[0], a[1]); w.y = cvt_pk_bf16(a[2], a[3]); w.z = cvt_pk_bf16(b[0], b[1]); w.w = cvt_pk_bf16(b[2], b[3]); return w; }
struct Epi1 {
    bf16* Z; float* LOGF; float* GLR; const float* rstd; const float* hg_lb;
    template <int T> __device__ __forceinline__ void plain(const f4 (&acc)[2][2][4][2], int row0, int col0) const {
#pragma unroll
        EPI_ROWS { const int row = row0 + ai * 128 + m * 16; const float rs = rstd[row];
#pragma unroll
            for (int bj = 0; bj < 2; ++bj) { f4 a = acc[ai][bj][m][0] * rs, b = acc[ai][bj][m][1] * rs;
#pragma unroll
                for (int i = 0; i < 4; ++i) { a[i] = act1<T>(a[i]); b[i] = act1<T>(b[i]); }
                *(u4*)(Z + (size_t)row * LDZ + col0 + bj * 128) = pack8(a, b); } }
    }
    __device__ __forceinline__ bool operator()(f4 (&acc)[2][2][4][2], const Unit& u, int wr, int wc, int fr, int fq) const {
        const int pn = u.pn, row0 = u.pm * 256 + wr * 64 + fr, col0 = pn * 256 + wc * 32 + 8 * fq;
        if (pn < 4) plain<0>(acc, row0, col0);
        else if (pn < 8) {
            float lb[2][8];
#pragma unroll
            for (int bj = 0; bj < 2; ++bj)
#pragma unroll
                for (int i = 0; i < 8; ++i) { const int c = col0 - ZC_HK + bj * 128 + i; lb[bj][i] = __builtin_amdgcn_rcpf(1.f + __expf(hg_lb[1024 + c] - hg_lb[c])); }
#pragma unroll
            EPI_ROWS { const int row = row0 + ai * 128 + m * 16; const float rs = rstd[row];
#pragma unroll
                for (int bj = 0; bj < 2; ++bj) { f4 lf[2], kk[2];
#pragma unroll
                    for (int n = 0; n < 2; ++n)
#pragma unroll
                        for (int i = 0; i < 4; ++i) { const float z = fminf(fmaxf(acc[ai][bj][m][n][i] * rs, -80.f), 80.f), e = __expf(-z), r = __builtin_amdgcn_rcpf(1.f + e);
                            const float l = lb[bj][4 * n + i], om = 1.f - l; lf[n][i] = __logf(l + om * r); kk[n][i] = om * (e * r); }
                    const int c = col0 + bj * 128;
                    *(u4*)(Z + (size_t)row * LDZ + c) = pack8(kk[0], kk[1]);
                    float* lp = LOGF + (size_t)row * 1024 + (c - ZC_HK); *(f4*)lp = lf[0]; *(f4*)(lp + 4) = lf[1]; } }
        }
        else if (pn < 12) plain<2>(acc, row0, col0);
        else if (pn < 16) plain<3>(acc, row0, col0);
        else if (pn < 18) plain<4>(acc, row0, col0);
        else if (pn < 24) plain<2>(acc, row0, col0);
        else if (pn < 28) plain<3>(acc, row0, col0);
        else if (pn < 44) plain<5>(acc, row0, col0);
        else if (wc == 0 && fq < 2) {
#pragma unroll
            EPI_ROWS { const int row = row0 + ai * 128 + m * 16; const float rs = rstd[row]; float* gp = GLR + (size_t)row * 16 + 8 * fq;
                *(f4*)gp = acc[ai][0][m][0] * rs; *(f4*)(gp + 4) = acc[ai][0][m][1] * rs; }
        }
        return true;
    }
};
struct Epi2 {
    const bf16* Z; bf16* MG;
    __device__ __forceinline__ bool operator()(f4 (&acc)[2][2][4][2], const Unit& u, int wr, int wc, int fr, int fq) const {
        const int row0 = u.pm * 256 + wr * 64 + fr, col0 = u.pn * 256 + wc * 32 + 8 * fq;
        const __amdgpu_buffer_rsrc_t mgr = wt_rsrc(MG, (size_t)MTOT * DM * 2);
#pragma unroll
        EPI_ROWS { const int row = row0 + ai * 128 + m * 16;
#pragma unroll
            for (int bj = 0; bj < 2; ++bj) { const int c = col0 + bj * 128; const bf16* gp = Z + (size_t)row * LDZ + ZC_MG + c;
                const u4 g1 = *(const u4*)(gp + DM);
                f4 h0 = (f4){bf_lo(g1.x), bf_hi(g1.x), bf_lo(g1.y), bf_hi(g1.y)}, h1 = (f4){bf_lo(g1.z), bf_hi(g1.z), bf_lo(g1.w), bf_hi(g1.w)};
                if (u.sub == 0) { const u4 g0 = *(const u4*)gp;
                    const f4 q0 = (f4){bf_lo(g0.x), bf_hi(g0.x), bf_lo(g0.y), bf_hi(g0.y)}, q1 = (f4){bf_lo(g0.z), bf_hi(g0.z), bf_lo(g0.w), bf_hi(g0.w)};
#pragma unroll
                    for (int i = 0; i < 4; ++i) { acc[ai][bj][m][0][i] *= q0[i] * __builtin_amdgcn_rcpf(h0[i]); acc[ai][bj][m][1][i] *= q1[i] * __builtin_amdgcn_rcpf(h1[i]); }
                } else wt_store16(mgr, (size_t)row * DM + c, pack8(acc[ai][bj][m][0] * h0, acc[ai][bj][m][1] * h1));
            } }
        return u.sub != 0;
    }
    __device__ __forceinline__ bool operator()(f4 (&acc)[2][2][4][2], f4 (&ex)[2], const Unit& u, int wr, int wc, int fr, int fq) const {
        { const int row = NPROMPT + 16 * u.pm + fr, c = u.pn * 256 + wr * 128 + wc * 32 + 8 * fq; const bf16* gp = Z + (size_t)row * LDZ + ZC_MG + c;
          const u4 g1 = *(const u4*)(gp + DM);
          f4 h0 = (f4){bf_lo(g1.x), bf_hi(g1.x), bf_lo(g1.y), bf_hi(g1.y)}, h1 = (f4){bf_lo(g1.z), bf_hi(g1.z), bf_lo(g1.w), bf_hi(g1.w)};
          if (u.sub == 0) { const u4 g0 = *(const u4*)gp;
              const f4 q0 = (f4){bf_lo(g0.x), bf_hi(g0.x), bf_lo(g0.y), bf_hi(g0.y)}, q1 = (f4){bf_lo(g0.z), bf_hi(g0.z), bf_lo(g0.w), bf_hi(g0.w)};
#pragma unroll
              for (int i = 0; i < 4; ++i) { ex[0][i] *= q0[i] * __builtin_amdgcn_rcpf(h0[i]); ex[1][i] *= q1[i] * __builtin_amdgcn_rcpf(h1[i]); }
          } else wt_store16(wt_rsrc(MG, (size_t)MTOT * DM * 2), (size_t)row * DM + c, pack8(ex[0] * h0, ex[1] * h1)); }
        return (*this)(acc, u, wr, wc, fr, fq);
    }
};
template <bool RES_BF16> struct EpiRes {
    const float* res_p; const float* res_s; const bf16* res_b; bf16* XB; float* SS;
    __device__ __forceinline__ bool operator()(f4 (&acc)[2][2][4][2], const Unit& u, int wr, int wc, int fr, int fq) const {
        const int row0 = u.pm * 256 + wr * 64 + fr, col0 = u.pn * 256 + wc * 32 + 8 * fq;
        const float* rb = u.pm < 32 ? res_p : res_s - (size_t)NPROMPT * DM;
        const __amdgpu_buffer_rsrc_t xbr = wt_rsrc(XB, (size_t)MTOT * DM * 2);
#pragma unroll
        EPI_ROWS { const int row = row0 + ai * 128 + m * 16; float ssq = 0.f;
#pragma unroll
            for (int bj = 0; bj < 2; ++bj) { const size_t off = (size_t)row * DM + col0 + bj * 128;
                f4 r0, r1;
                if (RES_BF16) { const u4 w = *(const u4*)(res_b + off); r0 = (f4){bf_lo(w.x), bf_hi(w.x), bf_lo(w.y), bf_hi(w.y)}; r1 = (f4){bf_lo(w.z), bf_hi(w.z), bf_lo(w.w), bf_hi(w.w)}; }
                else { r0 = *(const f4*)(rb + off); r1 = *(const f4*)(rb + off + 4); }
                const f4 o0 = acc[ai][bj][m][0] + r0, o1 = acc[ai][bj][m][1] + r1;
                wt_store16(xbr, off, pack8(o0, o1));
                ssq += (o0[0] * o0[0] + o0[1] * o0[1]) + (o0[2] * o0[2] + o0[3] * o0[3]) + (o1[0] * o1[0] + o1[1] * o1[1]) + (o1[2] * o1[2] + o1[3] * o1[3]); }
            ssq += __shfl_xor(ssq, 16); ssq += __shfl_xor(ssq, 32);
            if (fq == 0) __hip_atomic_store((unsigned*)(SS + ((size_t)u.pn * MTOT + row) * 4 + wc), __float_as_uint(ssq), __ATOMIC_RELAXED, __HIP_MEMORY_SCOPE_AGENT); }
        return true;
    }
    LAS float* xs;
    __device__ __forceinline__ bool operator()(f4 (&acc)[2][2][4][2], f4 (&ex)[2], const Unit& u, int wr, int wc, int fr, int fq) const {
        const int row = NPROMPT + 16 * u.pm + fr; const size_t off = (size_t)row * DM + u.pn * 256 + wr * 128 + wc * 32 + 8 * fq;
        f4 r0, r1;
        if (RES_BF16) { const u4 w = *(const u4*)(res_b + off); r0 = (f4){bf_lo(w.x), bf_hi(w.x), bf_lo(w.y), bf_hi(w.y)}; r1 = (f4){bf_lo(w.z), bf_hi(w.z), bf_lo(w.w), bf_hi(w.w)}; }
        else { const float* rp = res_s + (off - (size_t)NPROMPT * DM); r0 = *(const f4*)rp; r1 = *(const f4*)(rp + 4); }
        const f4 o0 = ex[0] + r0, o1 = ex[1] + r1;
        wt_store16(wt_rsrc(XB, (size_t)MTOT * DM * 2), off, pack8(o0, o1));
        float sx = (o0[0] * o0[0] + o0[1] * o0[1]) + (o0[2] * o0[2] + o0[3] * o0[3]) + (o1[0] * o1[0] + o1[1] * o1[1]) + (o1[2] * o1[2] + o1[3] * o1[3]);
        sx += __shfl_xor(sx, 16); sx += __shfl_xor(sx, 32);
        if (wr == 1 && fq == 0) xs[wc * 16 + fr] = sx;
        asm volatile("s_waitcnt lgkmcnt(0)" ::: "memory"); __builtin_amdgcn_s_barrier(); asm volatile("" ::: "memory");
        if (wr == 0 && fq == 0) __hip_atomic_store((unsigned*)(SS + ((size_t)u.pn * MTOT + row) * 4 + wc), __float_as_uint(sx + xs[wc * 16 + fr]), __ATOMIC_RELAXED, __HIP_MEMORY_SCOPE_AGENT);
        return (*this)(acc, u, wr, wc, fr, fq);
    }
};
__device__ __forceinline__ float row_rstd(const float* SS, int row, int fq) {
    const f4 a = *(const f4*)(SS + ((size_t)(2 * fq) * MTOT + row) * 4), b = *(const f4*)(SS + ((size_t)(2 * fq + 1) * MTOT + row) * 4);
    float s = ((a[0] + a[1]) + (a[2] + a[3])) + ((b[0] + b[1]) + (b[2] + b[3]));
    s += __shfl_xor(s, 16); s += __shfl_xor(s, 32);
    return __builtin_amdgcn_rsqf(s * (1.f / DM) + EPS);
}
struct EpiPle {
    bf16* PLEF;
    __device__ __forceinline__ bool operator()(f4 (&acc)[2][2][4][2], const Unit& u, int wr, int wc, int fr, int fq) const {
        const int row0 = u.pm * 256 + wr * 64 + fr, col0 = u.pn * 256 + wc * 32 + 8 * fq;
#pragma unroll
        EPI_ROWS { const int row = row0 + ai * 128 + m * 16;
#pragma unroll
            for (int bj = 0; bj < 2; ++bj) { *(u4*)(PLEF + (size_t)row * (2 * DM) + u.pn * 512 + (col0 - u.pn * 256) + bj * 128) = pack8(acc[ai][bj][m][0], acc[ai][bj][m][1]); asm volatile("" ::: "memory"); } }
        return true;
    }
    __device__ __forceinline__ bool operator()(f4 (&acc)[2][2][4][2], f4 (&ex)[2], const Unit& u, int wr, int wc, int fr, int fq) const {
        *(u4*)(PLEF + (size_t)(NPROMPT + 16 * u.pm + fr) * (2 * DM) + u.pn * 512 + wr * 128 + wc * 32 + 8 * fq) = pack8(ex[0], ex[1]); asm volatile("" ::: "memory");
        return (*this)(acc, u, wr, wc, fr, fq);
    }
};
struct Epi4 {
    const float* SS; bf16* ACT;
    __device__ __forceinline__ bool operator()(f4 (&acc)[2][2][4][2], const Unit& u, int wr, int wc, int fr, int fq) const {
        const int row0 = u.pm * 256 + wr * 64 + fr, col0 = u.pn * 128 + wc * 32 + 8 * fq;
#pragma unroll
        EPI_ROWS { const int row = row0 + ai * 128 + m * 16; const float rs = row_rstd(SS, row, fq); f4 o[2];
#pragma unroll
            for (int n = 0; n < 2; ++n)
#pragma unroll
                for (int i = 0; i < 4; ++i) { const float gt = acc[ai][0][m][n][i] * rs, up = acc[ai][1][m][n][i] * rs; o[n][i] = gt * sigm(gt) * up; }
            *(u4*)(ACT + (size_t)row * DFF + col0) = pack8(o[0], o[1]); }
        return true;
    }
};
struct Epi6 {
    const float* SS; const bf16* PLEF; const bf16* XB; float* XR; float* SSF; float* SSFX; const float* lnf; unsigned* cnt;
    __device__ __forceinline__ bool operator()(f4 (&acc)[2][2][4][2], f4 (&ex)[2], const Unit& u, int wr, int wc, int fr, int fq) const {
        const int row0 = u.pm * 256 + wr * 64 + fr, col0 = u.pn * 256 + wc * 32 + 8 * fq;
        const int rowx = NPROMPT + 16 * u.pm + fr, colx = u.pn * 256 + wr * 128 + wc * 32 + 8 * fq;
#pragma unroll
        EPI_ROWS { const int row = row0 + ai * 128 + m * 16; const float rs = row_rstd(SS, row, fq); float ssq = 0.f;
#pragma unroll
            for (int bj = 0; bj < 2; ++bj) { const size_t off = (size_t)row * DM + col0 + bj * 128;
#pragma unroll
                for (int n = 0; n < 2; ++n) { const v2u pw = *(const v2u*)(PLEF + (size_t)row * (2 * DM) + u.pn * 512 + (col0 - u.pn * 256) + bj * 128 + 4 * n); f4 o = acc[ai][bj][m][n];
                    o[0] = sigm(o[0] * rs) * bf_lo(pw.x); o[1] = sigm(o[1] * rs) * bf_hi(pw.x); o[2] = sigm(o[2] * rs) * bf_lo(pw.y); o[3] = sigm(o[3] * rs) * bf_hi(pw.y);
                    const v2u xw = *(const v2u*)(XB + off + 4 * n);
                    o[0] += bf_lo(xw.x); o[1] += bf_hi(xw.x); o[2] += bf_lo(xw.y); o[3] += bf_hi(xw.y);
                    ssq += (o[0] * o[0] + o[1] * o[1]) + (o[2] * o[2] + o[3] * o[3]); acc[ai][bj][m][n] = o; } }
            ssq += __shfl_xor(ssq, 16); ssq += __shfl_xor(ssq, 32);
            if (fq == 0) __hip_atomic_store((unsigned*)(SSF + ((size_t)u.pn * MTOT + row) * 4 + wc), __float_as_uint(ssq), __ATOMIC_RELAXED, __HIP_MEMORY_SCOPE_AGENT); }
        { const float rs = row_rstd(SS, rowx, fq); float ssq = 0.f; const size_t off = (size_t)rowx * DM + colx;
#pragma unroll
          for (int n = 0; n < 2; ++n) { const v2u pw = *(const v2u*)(PLEF + (size_t)rowx * (2 * DM) + u.pn * 512 + (colx - u.pn * 256) + 4 * n); f4 o = ex[n];
              o[0] = sigm(o[0] * rs) * bf_lo(pw.x); o[1] = sigm(o[1] * rs) * bf_hi(pw.x); o[2] = sigm(o[2] * rs) * bf_lo(pw.y); o[3] = sigm(o[3] * rs) * bf_hi(pw.y);
              const v2u xw = *(const v2u*)(XB + off + 4 * n);
              o[0] += bf_lo(xw.x); o[1] += bf_hi(xw.x); o[2] += bf_lo(xw.y); o[3] += bf_hi(xw.y);
              ssq += (o[0] * o[0] + o[1] * o[1]) + (o[2] * o[2] + o[3] * o[3]); ex[n] = o; }
          ssq += __shfl_xor(ssq, 16); ssq += __shfl_xor(ssq, 32);
          if (fq == 0) __hip_atomic_store((unsigned*)(SSFX + ((size_t)u.pn * NSAMPLE + (rowx - NPROMPT)) * 8 + wr * 4 + wc), __float_as_uint(ssq), __ATOMIC_RELAXED, __HIP_MEMORY_SCOPE_AGENT); }
        asm volatile("s_waitcnt vmcnt(0)" ::: "memory");
        unsigned* c = cnt + 64 * u.pm;
        if (fr == 0 && fq == 0) __hip_atomic_fetch_add(c, 1u, __ATOMIC_RELAXED, __HIP_MEMORY_SCOPE_AGENT);
        if (wr == 0 && wc == 0) { unsigned sp = 0;
            while ((unsigned)__builtin_amdgcn_readfirstlane((int)__hip_atomic_load(c, __ATOMIC_RELAXED, __HIP_MEMORY_SCOPE_AGENT)) < 64u && ++sp < (1u << 22)) __builtin_amdgcn_s_sleep(2);
            __builtin_amdgcn_fence(__ATOMIC_ACQUIRE, "agent");
            asm volatile("s_waitcnt vmcnt(0)" ::: "memory"); }
        asm volatile("" ::: "memory"); __builtin_amdgcn_s_barrier(); asm volatile("" ::: "memory");
#pragma unroll
        EPI_ROWS { const int row = row0 + ai * 128 + m * 16; const float rsf = row_rstd(SSF, row, fq);
#pragma unroll
            for (int bj = 0; bj < 2; ++bj) { const size_t off = (size_t)row * DM + col0 + bj * 128; const int c0 = col0 + bj * 128;
#pragma unroll
                for (int n = 0; n < 2; ++n) *(f4*)(XR + off + 4 * n) = acc[ai][bj][m][n] * rsf * *(const f4*)(lnf + c0 + 4 * n); } }
        { float sx = 0.f;
#pragma unroll
          for (int p = 0; p < 2; ++p) { const float* sp = SSFX + ((size_t)(2 * fq + p) * NSAMPLE + (rowx - NPROMPT)) * 8; const f4 a = *(const f4*)sp, b = *(const f4*)(sp + 4);
              sx += ((a[0] + a[1]) + (a[2] + a[3])) + ((b[0] + b[1]) + (b[2] + b[3])); }
          sx += __shfl_xor(sx, 16); sx += __shfl_xor(sx, 32);
          const float rsf = __builtin_amdgcn_rsqf(sx * (1.f / DM) + EPS);
#pragma unroll
          for (int n = 0; n < 2; ++n) *(f4*)(XR + (size_t)rowx * DM + colx + 4 * n) = ex[n] * rsf * *(const f4*)(lnf + colx + 4 * n); }
        return true;
    }
};
#undef EPI_ROWS
}

namespace scan {
typedef short v4i16_t __attribute__((ext_vector_type(4)));
__device__ __forceinline__ s16x4 vtr(const LAS unsigned char* p) { return __builtin_bit_cast(s16x4, __builtin_amdgcn_ds_read_tr16_b64_v4i16((LAS v4i16_t*)p)); }
__device__ __forceinline__ bf16x8 cat8(s16x4 lo, s16x4 hi) { return (bf16x8){lo[0], lo[1], lo[2], lo[3], hi[0], hi[1], hi[2], hi[3]}; }
template <int CTRL> __device__ __forceinline__ float dpp_mov(float v) { return __builtin_bit_cast(float, __builtin_amdgcn_update_dpp(0, __builtin_bit_cast(int, v), CTRL, 0xF, 0xF, true)); }
__device__ __forceinline__ float row16_sum(float v) { v += dpp_mov<0xB1>(v); v += dpp_mov<0x4E>(v); v += dpp_mov<0x141>(v); v += dpp_mov<0x140>(v); return v; }
typedef float f32x2_t __attribute__((ext_vector_type(2))); typedef __bf16 bf16x2_t __attribute__((ext_vector_type(2)));
__device__ __forceinline__ unsigned cvtpk(float lo, float hi) { f32x2_t v = {lo, hi}; bf16x2_t b = __builtin_convertvector(v, bf16x2_t); return __builtin_bit_cast(unsigned, b); }
__device__ __forceinline__ float logsig(float x) { return fminf(x, 0.f) - __logf(1.f + __expf(-fabsf(x))); }
struct Tensors { const bf16* Z; bf16* Zw; unsigned char* AD; float* LFS; const float* LOGF; const float* GLR; const float* wgk; const float* bgk; const float* hg_gain; const float* gla_gain; bf16* BR;
                 const float* st_h; const float* st_g; float* out; };
constexpr int AD_BYTES = 3072;
__device__ __forceinline__ void glds16(const void* gsrc, unsigned lds_dst) { unsigned keep;
    asm volatile("s_mov_b32 %0, m0\n\ts_mov_b32 m0, %2\n\ts_nop 0\n\tglobal_load_lds_dwordx4 %1, off\n\ts_mov_b32 m0, %0" : "=&s"(keep) : "v"(gsrc), "s"(lds_dst) : "memory"); }
__device__ __forceinline__ int fsw(int row) { return (2 * (row & 7)) ^ ((row >> 3) & 1); }
template <int KIND>
__device__ __forceinline__ void prepass_items(LAS unsigned char* lds, const Tensors& T, int bx, int G, int tid) {
    constexpr int RP = 288, TILE = 32 * RP, O_QE = 0, O_KE = TILE, NSEQ = KIND ? 16 : 32, SEQ0 = KIND ? 0 : 16, NH = KIND ? GLH : HGH;
    asm volatile("" : "+v"(tid));
    const int lane = tid & 63, wave = __builtin_amdgcn_readfirstlane(tid >> 6), l15 = lane & 15, g = lane >> 4, q4 = l15 >> 2, kc = 16 * wave + l15;
    const int wbase = 4 * g * RP + ((((kc >> 3) ^ (2 * g))) << 4) + (kc & 7) * 2;
    for (int it = bx; it < NSEQ * (SEQ / 32); it += G) {
        const int sq = it >> 6, n = it & 63, b = sq / NH, h = sq % NH;
        const int qcol = KIND ? ZC_GQ + h * 128 : ZC_HQ + h * 128, kcol = KIND ? ZC_GK + h * 128 : ZC_HK + h * 128;
        const size_t r0 = (size_t)(b * SEQ + n * 32);
        unsigned char* ad = T.AD + ((size_t)(SEQ0 + sq) * (SEQ / 32) + n) * AD_BYTES;
        float lf[8]; unsigned short qh[8], kh[8];
#pragma unroll
        for (int tt = 0; tt < 2; ++tt) {
            if (KIND) { const float* gp = T.GLR + (r0 + 16 * tt + l15) * 16 + 8 * (g & 1); const f32x4 g0 = *(const f32x4*)gp, g1 = *(const f32x4*)(gp + 4);
                float x[8] = {g0[0], g0[1], g0[2], g0[3], g1[0], g1[1], g1[2], g1[3]};
#pragma unroll
                for (int e = 0; e < 8; ++e) { const float hi = __uint_as_float(f2bf(x[e]) << 16); x[e] = g >= 2 ? x[e] - hi : hi; }
                v4u a; a.x = cvtpk(x[0], x[1]); a.y = cvtpk(x[2], x[3]); a.z = cvtpk(x[4], x[5]); a.w = cvtpk(x[6], x[7]);
                const float* wp = T.wgk + (size_t)(8 * (g & 1)) * 512 + h * 128 + kc; v4u w;
                w.x = cvtpk(wp[0], wp[512]); w.y = cvtpk(wp[1024], wp[1536]); w.z = cvtpk(wp[2048], wp[2560]); w.w = cvtpk(wp[3072], wp[3584]);
                const float bgv = T.bgk[h * 128 + kc];
                const f32x4 d = __builtin_amdgcn_mfma_f32_16x16x32_bf16(__builtin_bit_cast(bf16x8, a), __builtin_bit_cast(bf16x8, w), (f32x4){bgv, bgv, bgv, bgv}, 0, 0, 0);
#pragma unroll
                for (int r = 0; r < 4; ++r) lf[4 * tt + r] = logsig(d[r]) * (1.4426950408889634f / 16.f); }
#pragma unroll
            for (int r = 0; r < 4; ++r) { const size_t row = r0 + 16 * tt + 4 * g + r;
                if (!KIND) lf[4 * tt + r] = T.LOGF[row * 1024 + h * 128 + kc] * 1.4426950408889634f;
                qh[4 * tt + r] = T.Zw[row * LDZ + qcol + kc]; kh[4 * tt + r] = T.Zw[row * LDZ + kcol + kc]; } }
        lf[1] += lf[0]; lf[2] += lf[1]; lf[3] += lf[2]; lf[5] += lf[4]; lf[6] += lf[5]; lf[7] += lf[6];
        float s0[4], s1[4];
#pragma unroll
        for (int j = 0; j < 4; ++j) { s0[j] = __shfl(lf[3], l15 + 16 * j); s1[j] = __shfl(lf[7], l15 + 16 * j); }
        const float h0 = (s0[0] + s0[1]) + (s0[2] + s0[3]), last = h0 + ((s1[0] + s1[1]) + (s1[2] + s1[3]));
        const float pre = g == 0 ? 0.f : (g == 1 ? s0[0] : (g == 2 ? s0[0] + s0[1] : s0[0] + s0[1] + s0[2]));
        const float pre1 = h0 + (g == 0 ? 0.f : (g == 1 ? s1[0] : (g == 2 ? s1[0] + s1[1] : s1[0] + s1[1] + s1[2])));
        const float ref = h0 + __shfl(lf[4], l15);
        const float eref = __builtin_amdgcn_exp2f(ref), elr = __builtin_amdgcn_exp2f(last - ref);
#pragma unroll
        for (int e = 0; e < 8; ++e) { const float cum = lf[e] + (e < 4 ? pre : pre1), E = __builtin_amdgcn_exp2f(cum - ref), Ei = __builtin_amdgcn_exp2f(ref - cum);
            const float q = bf2f(qh[e]) * E, k = bf2f(kh[e]) * Ei; const int o = wbase + ((e >> 2) * 16 + (e & 3)) * RP;
            const unsigned a = cvtpk(q, q * eref), c = cvtpk(k, k * elr);
            *(LAS bf16*)(lds + O_QE + o) = (bf16)a; *(LAS bf16*)(lds + O_KE + o) = (bf16)c;
            const size_t row = r0 + (e >> 2) * 16 + 4 * g + (e & 3);
            T.Zw[row * LDZ + qcol + kc] = (bf16)(a >> 16); T.Zw[row * LDZ + kcol + kc] = (bf16)(c >> 16); }
        if (g == 0) *(float*)(ad + 2048 + kc * 4) = __builtin_amdgcn_exp2f(last);
        __syncthreads();
        if (wave < 3) { const int st = wave == 2 ? 1 : 0, tt = wave == 0 ? 0 : 1; f32x4 d = (f32x4){0.f, 0.f, 0.f, 0.f};
#pragma unroll
            for (int ks = 0; ks < 4; ++ks) { const int co = l15 * RP + ((((4 * ks + g) ^ (2 * q4))) << 4);
                d = __builtin_amdgcn_mfma_f32_16x16x32_bf16(*(const LAS bf16x8*)(lds + O_KE + 16 * st * RP + co), *(const LAS bf16x8*)(lds + O_QE + 16 * tt * RP + co), d, 0, 0, 0); }
            if (st == tt) {
#pragma unroll
                for (int r = 0; r < 4; ++r) d[r] = l15 >= 4 * g + r ? d[r] : 0.f; }
            *(v2u*)(ad + ((tt * 4 + g) * 16 + l15) * 16 + st * 8) = (v2u){cvtpk(d[0], d[1]), cvtpk(d[2], d[3])};
        } else if (wave == 3) *(v2u*)(ad + (g * 16 + l15) * 16 + 8) = (v2u){0u, 0u};
        __syncthreads();
    }
}

template <int NV>
__device__ __forceinline__ void prompt_scan(LAS unsigned char* lds, const Tensors& T, int b, int h, int tid) {
    constexpr int KIND = NV - 1, V = 128 * NV, NST = 3, NCH = SEQ / 32; constexpr bool GLDS = NV == 1;
    constexpr int O_QIN = 0, O_KOUT = 8192, O_V = 16384, O_G = 16384 + 8192 * NV, O_AD = O_G + (GLDS ? 8192 * NV : 0), STG = O_AD + AD_BYTES, O_RED = NST * STG, O_DUMMY = O_RED + 2048;
    constexpr int NPG = GLDS ? 8 * NV : 0, NP = 19 + 8 * NV + NPG, PPW = (NP + 7) / 8;
    static_assert(O_DUMMY + 1024 <= RING_BYTES, "scan LDS");
    asm volatile("" : "+v"(tid));
    const int lane = tid & 63, wave = __builtin_amdgcn_readfirstlane(tid >> 6), l15 = lane & 15, g = lane >> 4;
    const int qcol = KIND ? ZC_GQ + h * 128 : ZC_HQ + h * 128, kcol = KIND ? ZC_GK + h * 128 : ZC_HK + h * 128;
    const int vcol = KIND ? ZC_GV + h * 256 : ZC_HV + h * 128, gcol = KIND ? ZC_GG + h * 256 : ZC_HG + h * 128, ocol = KIND ? 1024 + h * 256 : h * 128;
    const float* gain = KIND ? T.gla_gain : T.hg_gain;
    const int vw = wave * 16 * NV;
    const unsigned char* adq = T.AD + ((size_t)((KIND ? 0 : 16) + b * (KIND ? GLH : HGH) + h) * NCH) * AD_BYTES;
    f32x4 S[NV][8];
#pragma unroll
    for (int nv = 0; nv < NV; ++nv)
#pragma unroll
        for (int kt = 0; kt < 8; ++kt) S[nv][kt] = (f32x4){0.f, 0.f, 0.f, 0.f};
    float gn[NV];
#pragma unroll
    for (int nv = 0; nv < NV; ++nv) gn[nv] = gain[vw + 16 * nv + l15];
    const unsigned lds0 = (unsigned)(uintptr_t)lds;
    const unsigned char* psrc[PPW]; int pdst[PPW]; unsigned pstr[PPW];
#pragma unroll
    for (int j_ = 0; j_ < PPW; ++j_) { const int i_ = wave + 8 * j_; const size_t r0_ = (size_t)(b * SEQ);
        if (i_ < 16) { const int p_ = i_ & 7, row_ = 4 * p_ + (lane >> 4), c_ = lane & 15;
            psrc[j_] = (const unsigned char*)(T.Z + (r0_ + row_) * LDZ + (i_ < 8 ? qcol : kcol) + ((c_ ^ fsw(row_)) << 3)); pdst[j_] = (i_ < 8 ? O_QIN : O_KOUT) + p_ * 1024; pstr[j_] = 32u * LDZ * 2u; }
        else if (i_ < 16 + 8 * NV + NPG) { const int gsel_ = i_ >= 16 + 8 * NV, p_ = i_ - 16 - (gsel_ ? 8 * NV : 0), row_ = NV == 1 ? 4 * p_ + (lane >> 4) : 2 * p_ + (lane >> 5), c_ = NV == 1 ? (lane & 15) : (lane & 31);
            psrc[j_] = (const unsigned char*)(T.Z + (r0_ + row_) * LDZ + (gsel_ ? gcol : vcol) + ((gsel_ ? c_ : (c_ ^ fsw(row_))) << 3)); pdst[j_] = (gsel_ ? O_G : O_V) + p_ * 1024; pstr[j_] = 32u * LDZ * 2u; }
        else if (i_ < NP) { const int p_ = i_ - 16 - 8 * NV - NPG; psrc[j_] = adq + p_ * 1024 + lane * 16; pdst[j_] = O_AD + p_ * 1024; pstr[j_] = AD_BYTES; }
        else { psrc[j_] = adq + 2048 + lane * 16; pdst[j_] = -1; pstr[j_] = AD_BYTES; } }
#define SCAN_DMA(m, st) do { const int m_ = (m); const bool live_ = m_ < NCH; const unsigned mm_ = live_ ? (unsigned)m_ : (unsigned)(NCH - 1); \
        _Pragma("unroll") for (int j_ = 0; j_ < PPW; ++j_) { const int dst_ = (live_ && pdst[j_] >= 0) ? (st) * STG + pdst[j_] : O_DUMMY; \
            glds16(psrc[j_] + (size_t)mm_ * pstr[j_], (unsigned)__builtin_amdgcn_readfirstlane((int)(lds0 + dst_))); } } while (0)
    SCAN_DMA(0, 0); SCAN_DMA(1, 1); asm volatile("s_waitcnt vmcnt(%0)" :: "n"(PPW) : "memory");
    __builtin_amdgcn_s_barrier(); asm volatile("" ::: "memory");
    int st = 0;
    for (int n = 0; n < NCH; ++n) {
        const size_t row0 = (size_t)(b * SEQ + n * 32);
        int l15_ = lane & 15; asm volatile("" : "+v"(l15_));
        const int q4 = l15_ >> 2, p4 = l15_ & 3;
        unsigned gtr[2][NV][4];
        if (!GLDS) {
#pragma unroll
            for (int tt = 0; tt < 2; ++tt)
#pragma unroll
                for (int nv = 0; nv < NV; ++nv)
#pragma unroll
                    for (int r = 0; r < 4; ++r) { const bf16* gp_ = T.Z + (row0 + 16 * tt + 4 * g + r) * LDZ + gcol + vw + 16 * nv + l15_;
                        asm volatile("global_load_ushort %0, %1, off" : "=v"(gtr[tt][nv][r]) : "v"(gp_) : "memory"); } }
        { const int stn = st + NST - 1 >= NST ? st - 1 : st + NST - 1; SCAN_DMA(n + NST - 1, stn); }
        const LAS unsigned char* sb = lds + st * STG;
        bf16x8 Bv[NV];
#pragma unroll
        for (int nv = 0; nv < NV; ++nv) { const int row = 4 * g + q4, ch = ((vw + 16 * nv) >> 3) + (p4 >> 1);
            const LAS unsigned char* vp = sb + O_V + row * (2 * V) + ((ch ^ fsw(row)) << 4) + (p4 & 1) * 8;
            Bv[nv] = cat8(vtr(vp), vtr(vp + 16 * (2 * V))); }
        f32x4 o[2][NV];
#pragma unroll
        for (int tt = 0; tt < 2; ++tt) { const bf16x8 A = *(const LAS bf16x8*)(sb + O_AD + ((tt * 4 + g) * 16 + l15_) * 16);
#pragma unroll
            for (int nv = 0; nv < NV; ++nv) o[tt][nv] = __builtin_amdgcn_mfma_f32_16x16x32_bf16(A, Bv[nv], (f32x4){0.f, 0.f, 0.f, 0.f}, 0, 0, 0); }
        bf16x8 Aq[2][4];
#pragma unroll
        for (int tt = 0; tt < 2; ++tt) { const int row = 16 * tt + l15_, f = fsw(row); const LAS unsigned char* qp = sb + O_QIN + row * 256 + (g & 1) * 8;
#pragma unroll
            for (int ks = 0; ks < 4; ++ks) Aq[tt][ks] = cat8(*(const LAS s16x4*)(qp + (((4 * ks + (g >> 1)) ^ f) << 4)), *(const LAS s16x4*)(qp + (((4 * ks + 2 + (g >> 1)) ^ f) << 4))); }
        bf16x8 Ak[8]; f32x4 d4[8];
        { const int row = 4 * g + q4; const LAS unsigned char* kb = sb + O_KOUT + row * 256 + (p4 & 1) * 8; const int fk = fsw(row);
#pragma unroll
          for (int kt = 0; kt < 8; ++kt) { const LAS unsigned char* kp = kb + (((2 * kt + (p4 >> 1)) ^ fk) << 4); Ak[kt] = cat8(vtr(kp), vtr(kp + 16 * 256)); d4[kt] = *(const LAS f32x4*)(sb + O_AD + 2048 + (16 * kt + 4 * g) * 4); } }
#pragma unroll
        for (int ks = 0; ks < 4; ++ks) { bf16x8 Bs[NV];
#pragma unroll
            for (int nv = 0; nv < NV; ++nv) { const f32x4 s0 = S[nv][2 * ks], s1 = S[nv][2 * ks + 1]; v4u w; w.x = cvtpk(s0[0], s0[1]); w.y = cvtpk(s0[2], s0[3]); w.z = cvtpk(s1[0], s1[1]); w.w = cvtpk(s1[2], s1[3]); Bs[nv] = __builtin_bit_cast(bf16x8, w); }
#pragma unroll
            for (int tt = 0; tt < 2; ++tt)
#pragma unroll
                for (int nv = 0; nv < NV; ++nv) o[tt][nv] = __builtin_amdgcn_mfma_f32_16x16x32_bf16(Aq[tt][ks], Bs[nv], o[tt][nv], 0, 0, 0); }
#pragma unroll
        for (int kt = 0; kt < 8; ++kt)
#pragma unroll
            for (int nv = 0; nv < NV; ++nv) S[nv][kt] = __builtin_amdgcn_mfma_f32_16x16x32_bf16(Ak[kt], Bv[nv], S[nv][kt] * d4[kt], 0, 0, 0);
        if (GLDS) {
#pragma unroll
        for (int tt = 0; tt < 2; ++tt)
#pragma unroll
            for (int nv = 0; nv < NV; ++nv)
#pragma unroll
                for (int r = 0; r < 4; ++r) gtr[tt][nv][r] = *(const LAS bf16*)(sb + O_G + ((16 * tt + 4 * g + r) * V + vw + 16 * nv + l15_) * 2); }
        LAS float* red = (LAS float*)(lds + O_RED + (n & 1) * 1024);
#pragma unroll
        for (int tt = 0; tt < 2; ++tt)
#pragma unroll
            for (int r = 0; r < 4; ++r) { float p = 0.f;
#pragma unroll
                for (int nv = 0; nv < NV; ++nv) p += o[tt][nv][r] * o[tt][nv][r];
                p = row16_sum(p);
                if (l15_ == 0) red[wave * 32 + 16 * tt + 4 * g + r] = p; }
        if (GLDS) { if (n == 0) asm volatile("s_waitcnt vmcnt(%0) lgkmcnt(0)" :: "n"(PPW) : "memory"); else asm volatile("s_waitcnt vmcnt(%0) lgkmcnt(0)" :: "n"(PPW + 8 * NV) : "memory"); }
        else { asm volatile("s_waitcnt vmcnt(%0) lgkmcnt(0)" :: "n"(PPW) : "memory");
#pragma unroll
            for (int tt = 0; tt < 2; ++tt)
#pragma unroll
                for (int nv = 0; nv < NV; ++nv) asm volatile("" : "+v"(gtr[tt][nv][0]), "+v"(gtr[tt][nv][1]), "+v"(gtr[tt][nv][2]), "+v"(gtr[tt][nv][3])); }
        __builtin_amdgcn_s_barrier(); asm volatile("" ::: "memory");
#pragma unroll
        for (int tt = 0; tt < 2; ++tt) { f32x4 ra = *(const LAS f32x4*)(red + (l15_ & 7) * 32 + 16 * tt + 4 * g);
#pragma unroll
            for (int r = 0; r < 4; ++r) { float x = ra[r]; x += dpp_mov<0xB1>(x); x += dpp_mov<0x4E>(x); x += dpp_mov<0x141>(x); ra[r] = x; }
#pragma unroll
            for (int r = 0; r < 4; ++r) { const int t = 16 * tt + 4 * g + r; const float rs = __builtin_amdgcn_rsqf(ra[r] * (1.f / V) + EPS);
#pragma unroll
                for (int nv = 0; nv < NV; ++nv) { const int vc = vw + 16 * nv + l15_;
                    const float y = o[tt][nv][r] * rs * gn[nv] * __uint_as_float(gtr[tt][nv][r] << 16); T.BR[(row0 + t) * DM + ocol + vc] = (bf16)cvtpk(y, y); } } }
        st = st + 1 == NST ? 0 : st + 1;
    }
#undef SCAN_DMA
    asm volatile("s_waitcnt vmcnt(0)" ::: "memory");
    float* so = T.out + (KIND ? OUT_GP + (size_t)(b * GLH + h) * 128 * V : OUT_HP + (size_t)(b * HGH + h) * 128 * V);
#pragma unroll
    for (int nv = 0; nv < NV; ++nv)
#pragma unroll
        for (int kt = 0; kt < 8; ++kt)
#pragma unroll
            for (int r = 0; r < 4; ++r) so[(size_t)(16 * kt + 4 * g + r) * V + vw + 16 * nv + l15] = S[nv][kt][r];
    __syncthreads();
}

constexpr int SS_QE = 0, SS_KE = 2048, SS_QIN = 4096, SS_KOUT = 6144, SS_DEC = 8192, SS_ATT = 8704, SS_WS = 8768  , SS_V = 9216  , SS_RED = 13312  ;
__device__ __forceinline__ void lds_barrier() { asm volatile("s_waitcnt lgkmcnt(0)" ::: "memory"); __builtin_amdgcn_s_barrier(); asm volatile("" ::: "memory"); }
template <int NV>
__device__ __forceinline__ void ss_load_small(const Tensors& T, int b, int h, int tid, unsigned short (&qh)[4], unsigned short (&kh)[4], float (&lf)[4], f32x4 (&gl)[4][4], float (&wk)[16], float& bgv,
                                              unsigned short (&vh)[NV], unsigned short (&gh)[NV], float (&gnv)[NV]) {
    constexpr int KIND = NV - 1, V = 128 * NV;
    const int qcol = KIND ? ZC_GQ + h * 128 : ZC_HQ + h * 128, kcol = KIND ? ZC_GK + h * 128 : ZC_HK + h * 128, vcol = KIND ? ZC_GV + h * 256 : ZC_HV + h * 128, gcol = KIND ? ZC_GG + h * 256 : ZC_HG + h * 128;
    const float* gain = KIND ? T.gla_gain : T.hg_gain; const int row0 = NPROMPT + b * DECS, k = tid & 127;
#pragma unroll
    for (int t = 0; t < 4; ++t) { const size_t row = (size_t)(row0 + t); qh[t] = T.Z[row * LDZ + qcol + k]; kh[t] = T.Z[row * LDZ + kcol + k];
        if (!KIND) lf[t] = T.LOGF[row * 1024 + h * 128 + k];
        else lf[t] = T.LFS[(size_t)(row - NPROMPT) * 512 + h * 128 + k]; }
    (void)gl; (void)wk; (void)bgv;
#pragma unroll
    for (int j = 0; j < NV; ++j) { const int i = tid + 512 * j, t = i / V, v = i % V; vh[j] = T.Z[(size_t)(row0 + t) * LDZ + vcol + v]; gh[j] = T.Z[(size_t)(row0 + t) * LDZ + gcol + v]; gnv[j] = gain[v]; }
}
template <int NV>
__device__ __forceinline__ int sample_scan(LAS unsigned char* lds, const Tensors& T, int b, int h, f32x4 (&sreg)[(128 * NV / 4) * 128 / 512], unsigned short (&qh)[4], unsigned short (&kh)[4], float (&lf)[4],
                                           f32x4 (&gl)[4][4], float (&wk)[16], float& bgv, unsigned short (&vh)[NV], unsigned short (&gh)[NV], float (&gnv)[NV], volatile LAS unsigned* nxt_word, int nitems, int tid) {
    constexpr int KIND = NV - 1, V = 128 * NV, V4 = V / 4, KR = 512 / V4, NR = 128 / KR, H = KIND ? GLH : HGH;
    asm volatile("" : "+v"(tid));
    const int lane = tid & 63, wave = __builtin_amdgcn_readfirstlane(tid >> 6);
    const int ocol = KIND ? 1024 + h * 256 : h * 128;
    const int row0 = NPROMPT + b * DECS;
    LAS float* qe = (LAS float*)(lds + SS_QE); LAS float* ke = (LAS float*)(lds + SS_KE); LAS float* qin = (LAS float*)(lds + SS_QIN); LAS float* kout = (LAS float*)(lds + SS_KOUT);
    LAS float* dec = (LAS float*)(lds + SS_DEC); LAS float* att = (LAS float*)(lds + SS_ATT); LAS float* wsum = (LAS float*)(lds + SS_WS); LAS float* vs = (LAS float*)(lds + SS_V); LAS float* red = (LAS float*)(lds + SS_RED);
    const int k = tid & 127;
    const int vq = tid % V4, kr = tid / V4;
    if (tid < 128) { float qv[4], kv[4];
#pragma unroll
        for (int t = 0; t < 4; ++t) { qv[t] = bf2f(qh[t]); kv[t] = bf2f(kh[t]); }
        lf[1] += lf[0]; lf[2] += lf[1]; lf[3] += lf[2];
#pragma unroll
        for (int t = 0; t < 4; ++t) { qe[t * 128 + k] = qv[t] * __expf(lf[t] - lf[2]); ke[t * 128 + k] = kv[t] * __expf(lf[2] - lf[t]); qin[t * 128 + k] = qv[t] * __expf(lf[t]); kout[t * 128 + k] = kv[t] * __expf(lf[3] - lf[t]); }
        dec[k] = __expf(lf[3]); }
#pragma unroll
    for (int j = 0; j < NV; ++j) vs[tid + 512 * j] = bf2f(vh[j]);
    lds_barrier();
    { const int pair = tid >> 5, t = pair >> 2, s = pair & 3, j = tid & 31; float a = 0.f;
#pragma unroll
      for (int i = 0; i < 4; ++i) a += qe[t * 128 + j + 32 * i] * ke[s * 128 + j + 32 * i];
      a += __shfl_xor(a, 16); a += __shfl_xor(a, 8); a += __shfl_xor(a, 4); a += __shfl_xor(a, 2); a += __shfl_xor(a, 1);
      if (j == 0) att[pair] = s <= t ? a : 0.f; }
    { float* sout = T.out + (KIND ? OUT_GS : OUT_HS) + (size_t)(b * H + h) * 128 * V;
      f32x4 vv[4], acc[4];
#pragma unroll
      for (int t = 0; t < 4; ++t) { vv[t] = *(const LAS f32x4*)(vs + t * V + 4 * vq); acc[t] = (f32x4){0.f, 0.f, 0.f, 0.f}; }
#pragma unroll
      for (int i = 0; i < NR; ++i) { const int k = kr + KR * i; const f32x4 s0 = sreg[i]; f32x4 sn = s0 * dec[k];
#pragma unroll
          for (int t = 0; t < 4; ++t) { acc[t] += s0 * qin[t * 128 + k]; sn += vv[t] * kout[t * 128 + k]; }
          *(f32x4*)(sout + (size_t)k * V + 4 * vq) = sn; }
#pragma unroll
      for (int t = 0; t < 4; ++t) *(LAS f32x4*)(red + (kr * 4 + t) * V + 4 * vq) = acc[t]; }
    const int nxt = (int)nxt_word[0];
    unsigned short gh2[NV]; float gnv2[NV];
#pragma unroll
    for (int j = 0; j < NV; ++j) { gh2[j] = gh[j]; gnv2[j] = gnv[j]; }
    if (nxt < nitems) { ss_load_small<NV>(T, nxt / H, nxt % H, tid, qh, kh, lf, gl, wk, bgv, vh, gh2, gnv2);
        const float* sn_ = (KIND ? T.st_g : T.st_h) + (size_t)nxt * 128 * V;
#pragma unroll
        for (int i = 0; i < NR; ++i) sreg[i] = *(const GAS f32x4*)(sn_ + (size_t)(kr + KR * i) * V + 4 * vq); }
    lds_barrier();
    float ov[NV];
#pragma unroll
    for (int j = 0; j < NV; ++j) { const int idx = tid + 512 * j, t = idx / V, v = idx % V; float o = 0.f;
#pragma unroll
        for (int kr = 0; kr < KR; ++kr) o += red[(kr * 4 + t) * V + v];
#pragma unroll
        for (int s = 0; s < 4; ++s) o += att[t * 4 + s] * vs[s * V + v];
        ov[j] = o; const float p = wave_sum(o * o); if (lane == 0) wsum[j * 8 + wave] = p; }
    lds_barrier();
#pragma unroll
    for (int j = 0; j < NV; ++j) { const int idx = tid + 512 * j, t = idx / V, v = idx % V; float tot = 0.f;
#pragma unroll
        for (int jj = 0; jj < NV; ++jj)
#pragma unroll
            for (int w = 0; w < 8; ++w) { const int tw = (w * 64 + 512 * jj) / V; tot += (tw == t) ? wsum[jj * 8 + w] : 0.f; }
        const float rs = __builtin_amdgcn_rsqf(tot * (1.f / V) + EPS); const size_t row = (size_t)(row0 + t);
        T.BR[row * DM + ocol + v] = (bf16)f2bf(ov[j] * rs * gnv[j] * bf2f(gh[j])); gh[j] = gh2[j]; gnv[j] = gnv2[j]; }
    lds_barrier();
    return nxt;
}
template <int NV>
__device__ __forceinline__ void sample_loop(LAS unsigned char* lds, const Tensors& T, volatile LAS unsigned* MISC, gu32* q, int tid) {
    constexpr int KIND = NV - 1, V = 128 * NV, V4 = V / 4, KR = 512 / V4, NR = 128 / KR, H = KIND ? GLH : HGH, NIT = DECB * H;
    if (tid == 0) MISC[16] = __hip_atomic_fetch_add(q, 1u, RLX_AGENT);
    __syncthreads();
    int cur = (int)MISC[16];
    __syncthreads();
    if (cur >= NIT) return;
    f32x4 sreg[NR]; unsigned short qh[4], kh[4], vh[NV], gh[NV]; float lf[4], wk[16], gnv[NV], bgv = 0.f; f32x4 gl[4][4];
    ss_load_small<NV>(T, cur / H, cur % H, tid, qh, kh, lf, gl, wk, bgv, vh, gh, gnv);
    { const int vq = tid % V4, kr = tid / V4; const float* sn_ = (KIND ? T.st_g : T.st_h) + (size_t)cur * 128 * V;
#pragma unroll
      for (int i = 0; i < NR; ++i) sreg[i] = *(const GAS f32x4*)(sn_ + (size_t)(kr + KR * i) * V + 4 * vq); }
    for (;;) {
        if (tid == 0) MISC[17] = __hip_atomic_fetch_add(q, 1u, RLX_AGENT);
        const int nxt = sample_scan<NV>(lds, T, cur / H, cur % H, sreg, qh, kh, lf, gl, wk, bgv, vh, gh, gnv, MISC + 17, NIT, tid);
        if (nxt >= NIT) break;
        cur = nxt;
    }
}
}

struct Args { const float* in[22]; float* out; unsigned char* ws; int ph_lo, ph_hi, li, pad; };
#ifndef MK_CUTS
#define MK_CUTS 0, 9
#endif
constexpr int N_PHASES = 8;
#ifndef SF_NUM
#define SF_NUM 9
#endif
constexpr int N_DEFER = 16 * (MTOT / 256);
enum { I_XP = 0, I_XS, I_STH, I_STG, I_PP, I_PS, I_HGLB, I_LN1, I_WIN, I_HGN, I_WGK, I_BGK, I_GLN, I_WBR, I_WOUT, I_LN2, I_WGU, I_WDN, I_LN3, I_WPLE, I_WPG, I_LNF };

__global__ void __launch_bounds__(NWAVES * 64, 2) mega_fwd(Args args) {
    extern __shared__ __attribute__((aligned(16))) unsigned char lds_raw[];
    LAS unsigned char* lds = (LAS unsigned char*)lds_raw;
    volatile LAS unsigned* MISC = (volatile LAS unsigned*)(lds + MISC_OFF);
    const int G = gridDim.x, bx = blockIdx.x;
#define FRESH_IDS int tid = threadIdx.x; asm volatile("" : "+v"(tid)); const int lane = tid & 63, wave = __builtin_amdgcn_readfirstlane(tid >> 6); (void)lane; (void)wave;
    unsigned char* ws = args.ws;
    gu32* ctl = (gu32*)(ws + WS_CTL);
    bf16* Win_t = (bf16*)(ws + WS_WIN); bf16* Wb_t = (bf16*)(ws + WS_WB); bf16* Wout_t = (bf16*)(ws + WS_WOUT); bf16* Wgu_t = (bf16*)(ws + WS_WGU);
    bf16* Wdn_t = (bf16*)(ws + WS_WDN); bf16* Wpg_t = (bf16*)(ws + WS_WPG); bf16* Wple_t = (bf16*)(ws + WS_WPLE);
    bf16* PB = (bf16*)(ws + WS_PB); float* RSTD1 = (float*)(ws + WS_RSTD1); float* GLR = (float*)(ws + WS_GLR);
    float* SS2 = (float*)(ws + WS_SS2); float* SS3 = (float*)(ws + WS_SS3); float* SSF = (float*)(ws + WS_SSF);
    bf16* BUFA = (bf16*)(ws + WS_BUFA); bf16* BUFB = (bf16*)(ws + WS_BUFB); float* LOGF = (float*)(ws + WS_LOGF);
    bf16* Z = (bf16*)(ws + WS_Z); bf16* ACT = (bf16*)(ws + WS_Z); bf16* PLEF = (bf16*)(args.out + OUT_Y);
    float* XR = args.out + OUT_Y;
    for (int u = threadIdx.x; u < (LDS_BYTES - LDSCTL_OFF) / 4; u += NWAVES * 64) ((LAS unsigned*)(lds + LDSCTL_OFF))[u] = 0u;
    __syncthreads();
    const int ph_lo = args.ph_lo, ph_hi = args.ph_hi; int nbar = 0;
#define IN(k) (ph_lo <= (k) && (k) < ph_hi)
    int my_xcc = (int)(xb_xcc_id() & 15u), xcc_fast = -1;
    if (threadIdx.x == 0) __hip_atomic_fetch_add(ctl + CW_XCC + 64 * my_xcc, 1u, RLX_AGENT);
#define XCC_DECIDE() do { volatile LAS int* xw_ = (volatile LAS int*)(lds + LDSCTL_OFF + 128); \
        if (threadIdx.x == 0) { int r_ = -1; if ((G % 8) == 0) { unsigned sp_ = 0; bool ok_ = false; \
                for (;;) { unsigned sum_ = 0; ok_ = true; for (int j_ = 0; j_ < 16; ++j_) { const unsigned c_ = __hip_atomic_load(ctl + CW_XCC + 64 * j_, RLX_AGENT); sum_ += c_; ok_ = ok_ && (c_ == (j_ < 8 ? (unsigned)(G / 8) : 0u)); } \
                    if (sum_ >= (unsigned)G || ++sp_ > (1u << 20)) break; __builtin_amdgcn_s_sleep(2); } \
                if (ok_) r_ = my_xcc; } \
            xw_[0] = r_; } \
        __syncthreads(); xcc_fast = __builtin_amdgcn_readfirstlane(xw_[0]); } while (0)
#define SEAM(k) do { if (IN(k) && IN((k) + 1)) { if (nbar == 0) XCC_DECIDE(); ++nbar; grid_barrier(ctl + CW_BAR + args.li * 4096, (unsigned)nbar, G, bx, xcc_fast); } } while (0)

    if (IN(0)) {
        FRESH_IDS
        const int gw = bx * NWAVES + wave, NGW = G * NWAVES; (void)gw; (void)NGW;
        {
            LAS unsigned* img = (LAS unsigned*)(lds + RING_OFF);
            int base = 0;
#define P0_MAT(Wp, ks, WTp, Kk, Nn, md) do { const P0Mat m_{Wp, ks, WTp, Kk, Nn, md, ((Kk) / 64) * (((Nn) + 255) / 256)}; \
                int t_ = bx - (base % G); if (t_ < 0) t_ += G;            \
                f32x4 va[8], vb[8]; \
                if (t_ < m_.tiles) p0_tile_load(m_, t_, va, tid); \
                for (; t_ < m_.tiles; t_ += G) { \
                    if (t_ + G < m_.tiles) p0_tile_load(m_, t_ + G, vb, tid); \
                    p0_tile_store(m_, t_, va, img, tid); \
                    _Pragma("unroll") for (int e = 0; e < 8; ++e) va[e] = vb[e]; } \
                base += m_.tiles; } while (0)
            P0_MAT(args.in[I_WIN], args.in[I_LN1], Win_t, DM, INCOLS, 1);
#undef P0_MAT
        }
        for (int i = bx * 512 + tid; i < (N1PAD - INCOLS) * DM / 8; i += G * 512) *(GAS v4u*)(Win_t + (size_t)INCOLS * DM + (size_t)i * 8) = (v4u){0u, 0u, 0u, 0u};
        for (int mb = bx; mb < MTOT / 32; mb += G) for (int m = mb * 32 + wave; m < mb * 32 + 32; m += NWAVES) {
            const float* xrow = m < NPROMPT ? args.in[I_XP] + (size_t)m * DM : args.in[I_XS] + (size_t)(m - NPROMPT) * DM;
            const GAS f32x4* xr = (const GAS f32x4*)xrow + lane; f32x4 v[8]; float s = 0.f;
#pragma unroll
            for (int j = 0; j < 8; ++j) { v[j] = xr[64 * j]; s += (v[j].x * v[j].x + v[j].y * v[j].y) + (v[j].z * v[j].z + v[j].w * v[j].w); }
            s = wave_sum(s);
            GAS v2u* o8 = (GAS v2u*)(BUFA + (size_t)m * DM) + lane;
#pragma unroll
            for (int j = 0; j < 8; ++j) o8[64 * j] = (v2u){pk2(v[j].x, v[j].y), pk2(v[j].z, v[j].w)};
            if (lane == 0) RSTD1[m] = __builtin_amdgcn_rsqf(s * (1.f / DM) + EPS);
            const float* prow = m < NPROMPT ? args.in[I_PP] + (size_t)m * PLE : args.in[I_PS] + (size_t)(m - NPROMPT) * PLE;
            const f32x4 pv = ((const GAS f32x4*)prow)[lane];
            ((GAS v2u*)(PB + (size_t)m * PLE))[lane] = (v2u){pk2(pv.x, pv.y), pk2(pv.z, pv.w)};
        }
    }
    SEAM(0);

    if (IN(1)) {
        pg8::Sched S{MTOT / 256, 29, (MTOT / 256) * 29, G, bx, 1, (const char*)BUFA, (const char*)Win_t, (size_t)256 * DM * 2, (size_t)256 * DM * 2, 0, 0, 28, 44};
        epi::Epi1 E{Z, LOGF, GLR, RSTD1, args.in[I_HGLB]};
        { const int r1 = (bx % 3) + 1;
          pg8::Sched Sa = S; Sa.icount = r1; pg8::gemm_phase(lds + RING_OFF, pg8::Gemm{DM, DM, DM / 64}, Sa, E);
          { FRESH_IDS
            LAS unsigned* img = (LAS unsigned*)(lds + RING_OFF);
            constexpr int T_GU = (DM / 64) * (2 * DFF / 256), T_DN = (DFF / 64) * (DM / 256), T_SQ = (DM / 64) * (DM / 256), T_BR = (1024 / 64) * (DM / 256), T_PL = (PLE / 64) * (DM / 256);
            constexpr int T_TOT = T_GU + T_DN + 2 * T_SQ + 2 * T_BR + T_PL;
#define P0_PICK(gid, m, lt) do { int r_ = (gid); \
                if (r_ < T_GU) { m = P0Mat{args.in[I_WGU], args.in[I_LN2], Wgu_t, DM, 2 * DFF, 2, T_GU}; lt = r_; } else { r_ -= T_GU; \
                if (r_ < T_DN) { m = P0Mat{args.in[I_WDN], nullptr, Wdn_t, DFF, DM, 0, T_DN}; lt = r_; } else { r_ -= T_DN; \
                if (r_ < T_SQ) { m = P0Mat{args.in[I_WOUT], nullptr, Wout_t, DM, DM, 0, T_SQ}; lt = r_; } else { r_ -= T_SQ; \
                if (r_ < T_SQ) { m = P0Mat{args.in[I_WPG], args.in[I_LN3], Wpg_t, DM, DM, 0, T_SQ}; lt = r_; } else { r_ -= T_SQ; \
                if (r_ < T_BR) { m = P0Mat{args.in[I_WBR], nullptr, Wb_t, 1024, DM, 0, T_BR}; lt = r_; } else { r_ -= T_BR; \
                if (r_ < T_BR) { m = P0Mat{args.in[I_WBR] + (size_t)1024 * DM, nullptr, Wb_t + (size_t)DM * 1024, 1024, DM, 0, T_BR}; lt = r_; } else { r_ -= T_BR; \
                m = P0Mat{args.in[I_WPLE], nullptr, Wple_t, PLE, DM, 0, T_PL}; lt = r_; } } } } } } } while (0)
            P0Mat ma{}, mb{}, mc{}; int la = 0, lb = 0, lc = 0; f32x4 va[8], vb[8], vc[8];
            if (bx < T_TOT) { P0_PICK(bx, ma, la); p0_tile_load(ma, la, va, tid); }
            if (bx + G < T_TOT) { P0_PICK(bx + G, mb, lb); p0_tile_load(mb, lb, vb, tid); }
            for (int gt = bx; gt < T_TOT; gt += G) {
                if (gt + 2 * G < T_TOT) { P0_PICK(gt + 2 * G, mc, lc); p0_tile_load(mc, lc, vc, tid); }
                p0_tile_store(ma, la, va, img, tid);
                ma = mb; la = lb; mb = mc; lb = lc;
#pragma unroll
                for (int e = 0; e < 8; ++e) { va[e] = vb[e]; vb[e] = vc[e]; } }
#undef P0_PICK
          }
          pg8::Sched Sb = S; Sb.i0 = r1; pg8::gemm_phase(lds + RING_OFF, pg8::Gemm{DM, DM, DM / 64}, Sb, E); }
        const int nfull = (MTOT / 256) * 29, rem = nfull % G, n_early = (G >= 96 && rem) ? G - rem : 0;
        if (n_early && bx >= rem) { pg8::SchedList SL{N_DEFER - n_early + (bx - rem), G, N_DEFER, MTOT / 256, 28, (const char*)BUFA, (const char*)Win_t, (size_t)256 * DM * 2, (size_t)256 * DM * 2};
            pg8::gemm_phase(lds + RING_OFF, pg8::Gemm{DM, DM, DM / 64}, SL, E); }
    }
    SEAM(1);

    if (IN(2)) {
        FRESH_IDS
        scan::Tensors T{Z, Z, ws + WS_AD, (float*)(ws + WS_AD + 10 * MiB), LOGF, GLR, args.in[I_WGK], args.in[I_BGK], args.in[I_HGN], args.in[I_GLN], BUFB, args.in[I_STH], args.in[I_STG], args.out};
        for (int i = bx * 512 + tid; i < NSAMPLE * 512; i += G * 512) { const int row = i >> 9, col = i & 511; float x = args.in[I_BGK][col];
            const float* gr = GLR + (size_t)(NPROMPT + row) * 16;
#pragma unroll
            for (int r = 0; r < 16; ++r) x += gr[r] * args.in[I_WGK][r * 512 + col];
            T.LFS[i] = scan::logsig(x) * (1.f / 16.f); }
        if (G >= 96) {
            gu32* cG = ctl + CW_PRE; gu32* cH = ctl + CW_PRE + 64;
            scan::prepass_items<1>(lds, T, bx, G, tid);
            const unsigned n_arr = xcc_fast >= 0 ? 8u : (unsigned)G;
            cnt_arrive_x(cG, ctl + CW_PSUB, xcc_fast, (unsigned)(G / 8));
            if (bx >= 16) scan::prepass_items<0>(lds, T, bx - 16, G - 16, tid);
            cnt_arrive_x(cH, ctl + CW_PSUB + 512, xcc_fast, (unsigned)(G / 8));
            if (bx < 16) { cnt_wait(cG, n_arr); scan::prompt_scan<2>(lds, T, bx >> 2, bx & 3, tid); }
            else if (bx < 48) { cnt_wait(cH, n_arr); scan::prompt_scan<1>(lds, T, (bx - 16) >> 3, (bx - 16) & 7, tid); }
            else { const int nfull = (MTOT / 256) * 29, rem = nfull % G, n_early = rem ? G - rem : 0, n_units = N_DEFER - n_early;
                const int idx = bx - 48, nb = (G - 48) / 16, blk = idx / 16, r16 = idx % 16, tail = (G - 48) - 16 * nb;
                const bool sf = blk < nb && r16 < SF_NUM;
                const int n_odd = nb * SF_NUM, n_even = (G - 48) - n_odd, hi = sf ? blk * SF_NUM + r16 : (blk < nb ? blk * (16 - SF_NUM) + (r16 - SF_NUM) : nb * (16 - SF_NUM) + r16);
                const int n_ev_units = 3 * n_even < n_units ? 3 * n_even : n_units; (void)tail;
                epi::Epi1 E{Z, LOGF, GLR, RSTD1, args.in[I_HGLB]};
                if (sf) {
                    cnt_wait(cH, n_arr);
                    scan::sample_loop<2>(lds, T, MISC, ctl + CW_Q, tid);
                    scan::sample_loop<1>(lds, T, MISC, ctl + CW_Q + 64, tid);
                    pg8::SchedList SL{n_ev_units + hi, n_odd, n_units, MTOT / 256, 28, (const char*)BUFA, (const char*)Win_t, (size_t)256 * DM * 2, (size_t)256 * DM * 2};
                    pg8::gemm_phase(lds + RING_OFF, pg8::Gemm{DM, DM, DM / 64}, SL, E);
                } else {
                    pg8::SchedList SL{hi, n_even, n_ev_units, MTOT / 256, 28, (const char*)BUFA, (const char*)Win_t, (size_t)256 * DM * 2, (size_t)256 * DM * 2};
                    pg8::gemm_phase(lds + RING_OFF, pg8::Gemm{DM, DM, DM / 64}, SL, E); } }
            if (bx >= 16) { const int j = bx >= 48 ? bx - 48 : (G - 48) + (bx - 16);
                pg8::SchedList SLP{j, G - 16, (NPROMPT / 256) * (DM / 256), NPROMPT / 256, 0, (const char*)PB, (const char*)Wple_t, (size_t)256 * PLE * 2, (size_t)256 * PLE * 2};
                epi::EpiPle E2{PLEF}; pg8::gemm_phase_t<true>(lds + RING_OFF, pg8::Gemm{PLE, PLE, PLE / 64}, SLP, E2); }
            cnt_wait(cH, n_arr);
        } else {
            scan::prepass_items<1>(lds, T, bx, G, tid);
            scan::prepass_items<0>(lds, T, bx, G, tid);
            ++nbar; grid_barrier(ctl + CW_BAR + args.li * 4096, (unsigned)nbar, G, bx, xcc_fast);
            { pg8::SchedList SL{bx, G, 16 * (MTOT / 256), MTOT / 256, 28, (const char*)BUFA, (const char*)Win_t, (size_t)256 * DM * 2, (size_t)256 * DM * 2};
              epi::Epi1 E{Z, LOGF, GLR, RSTD1, args.in[I_HGLB]};
              pg8::gemm_phase(lds + RING_OFF, pg8::Gemm{DM, DM, DM / 64}, SL, E); }
            for (int sq = bx; sq < 48; sq += G) {
                if (sq < 16) scan::prompt_scan<2>(lds, T, sq >> 2, sq & 3, tid);
                else scan::prompt_scan<1>(lds, T, (sq - 16) >> 3, (sq - 16) & 7, tid);
            }
        }
        scan::sample_loop<2>(lds, T, MISC, ctl + CW_Q, tid);
        scan::sample_loop<1>(lds, T, MISC, ctl + CW_Q + 64, tid);
    }
    SEAM(2);

    const bool panel_ok = (G == 256);
    int my_pm = 0; { pg8::Sched S0{NPROMPT / 256, DM / 256, (NPROMPT / 256) * (DM / 256), G, bx, 1, nullptr, nullptr, 0, 0, 0, 0}; pg8::Unit u0; if (S0.next(0, u0)) my_pm = u0.pm; }
    const bool ple_first = false, ple_in_p2 = (G >= 96) && IN(2);
#define PLE_GEMM() do { pg8::Sched S2{NPROMPT / 256, DM / 256, (NPROMPT / 256) * (DM / 256), G, bx, 1, (const char*)PB, (const char*)Wple_t, (size_t)256 * PLE * 2, (size_t)256 * PLE * 2, 0, 0}; \
        epi::EpiPle E2{PLEF}; pg8::gemm_phase_t<true>(lds + RING_OFF, pg8::Gemm{PLE, PLE, PLE / 64}, S2, E2); } while (0)
    if (IN(3)) {
        if (ple_first) PLE_GEMM();
        pg8::Sched S{NPROMPT / 256, DM / 256, (NPROMPT / 256) * (DM / 256), G, bx, 2, (const char*)BUFB, (const char*)Wb_t, (size_t)256 * DM * 2, (size_t)256 * 1024 * 2, (size_t)1024 * 2, (size_t)DM * 1024 * 2};
        epi::Epi2 E{Z, BUFA};
        pg8::gemm_phase_t<true>(lds + RING_OFF, pg8::Gemm{DM, 1024, 1024 / 64}, S, E);
    }
    if (panel_ok) { if (IN(3) && IN(4)) panel_barrier(ctl + CW_PB3 + 64 * my_pm, 8u, false);       } else SEAM(3);

    if (IN(4)) {
        pg8::Sched S{NPROMPT / 256, DM / 256, (NPROMPT / 256) * (DM / 256), G, bx, 1, (const char*)BUFA, (const char*)Wout_t, (size_t)256 * DM * 2, (size_t)256 * DM * 2, 0, 0};
        epi::EpiRes<false> E{args.in[I_XP], args.in[I_XS], nullptr, BUFB, SS2, (LAS float*)(lds + XS_OFF)};
        pg8::gemm_phase_t<true>(lds + RING_OFF, pg8::Gemm{DM, DM, DM / 64}, S, E);
        if (!ple_first && !ple_in_p2) PLE_GEMM();
    }
#undef PLE_GEMM
    if (ple_in_p2) { if (IN(4) && IN(5)) { if (nbar == 0) XCC_DECIDE(); ++nbar; grid_barrier(ctl + CW_BAR + args.li * 4096, (unsigned)nbar, G, bx, xcc_fast, false); } }
    else SEAM(4);

    if (IN(5)) {
        pg8::Sched S{MTOT / 256, 2 * DFF / 256, (MTOT / 256) * (2 * DFF / 256), G, bx, 1, (const char*)BUFB, (const char*)Wgu_t, (size_t)256 * DM * 2, (size_t)256 * DM * 2, 0, 0};
        epi::Epi4 E{SS2, ACT};
        pg8::gemm_phase(lds + RING_OFF, pg8::Gemm{DM, DM, DM / 64}, S, E);
    }
    SEAM(5);

    if (IN(6)) {
        pg8::Sched S{NPROMPT / 256, DM / 256, (NPROMPT / 256) * (DM / 256), G, bx, 1, (const char*)ACT, (const char*)Wdn_t, (size_t)256 * DFF * 2, (size_t)256 * DFF * 2, 0, 0};
        epi::EpiRes<true> E{nullptr, nullptr, BUFB, BUFA, SS3, (LAS float*)(lds + XS_OFF)};
        pg8::gemm_phase_t<true>(lds + RING_OFF, pg8::Gemm{DFF, DFF, DFF / 64}, S, E);
    }
    if (panel_ok) { if (IN(6) && IN(7)) panel_barrier(ctl + CW_PB6 + 64 * my_pm, 8u, false);       } else SEAM(6);

    if (IN(7)) {
        pg8::Sched S{NPROMPT / 256, DM / 256, (NPROMPT / 256) * (DM / 256), G, bx, 1, (const char*)BUFA, (const char*)Wpg_t, (size_t)256 * DM * 2, (size_t)256 * DM * 2, 0, 0};
        epi::Epi6 E{SS3, PLEF, BUFA, XR, SSF, (float*)(ws + WS_SSFX), args.in[I_LNF], (unsigned*)(ctl + CW_PAN)};
        pg8::gemm_phase_t<true>(lds + RING_OFF, pg8::Gemm{DM, DM, DM / 64}, S, E);
    }
}

extern "C" void kernel_launch(void* const* d_in, const int* in_sizes, int n_in, void* d_out, int out_size, void* d_ws, size_t ws_size, hipStream_t stream) {
    static int grid = 0;
    if (grid == 0) {
        if (n_in != 22 || (size_t)out_size != OUT_END || ws_size < WS_END) { fprintf(stderr, "kernel_launch: unexpected shapes (n_in %d, out %d, ws %zu): nothing launched\n", n_in, out_size, ws_size); grid = -1; return; }
        int dev = 0, cus = 0;
        if (hipGetDevice(&dev) != hipSuccess || hipDeviceGetAttribute(&cus, hipDeviceAttributeMultiprocessorCount, dev) != hipSuccess) { grid = -1; return; }
        if (hipFuncSetAttribute((const void*)mega_fwd, hipFuncAttributeMaxDynamicSharedMemorySize, LDS_BYTES) != hipSuccess) { fprintf(stderr, "kernel_launch: hipFuncSetAttribute failed\n"); grid = -1; return; }
        int per_cu = 0;
        if (hipOccupancyMaxActiveBlocksPerMultiprocessor(&per_cu, (const void*)mega_fwd, NWAVES * 64, LDS_BYTES) != hipSuccess || per_cu < 1) { fprintf(stderr, "kernel_launch: occupancy query reports %d workgroups per CU\n", per_cu); }
        (void)hipGetLastError();
        if (per_cu < 1) { grid = -1; return; }
        grid = cus;
    }
    if (grid < 0) return;
    (void)hipMemsetAsync((char*)d_ws + WS_CTL, 0, CTL_ZERO_BYTES, stream);
    Args a{};
    for (int i = 0; i < 22; ++i) a.in[i] = (const float*)d_in[i];
    a.out = (float*)d_out; a.ws = (unsigned char*)d_ws;
    static const int cuts[] = { MK_CUTS };
    constexpr int NL = (int)(sizeof(cuts) / sizeof(int)) - 1;
    for (int li = 0; li < NL; ++li) { a.ph_lo = cuts[li]; a.ph_hi = cuts[li + 1]; a.li = li; hipLaunchKernelGGL(mega_fwd, dim3(grid), dim3(NWAVES * 64), LDS_BYTES, stream, a); }
}
```
